# Optimizing an MI355X kernel written in HIP

```python
import jax, jax.numpy as jnp
from jax import lax
import numpy as np

D_MODEL = 1024
BATCH = 4
SEQ = 4096
DEPTH = 1

GRID_W = 64
EPS = 1e-6
D_CONV = 1024
CONV_WIDTH = 3
N_HEADS = 8
N_KV_HEADS = 2
HEAD_DIM = 128
AXIS_DIM = HEAD_DIM // 2
ROPE_THETA = 10000.0
Q_BLOCK = 128
D_Q = N_HEADS * HEAD_DIM
D_KV = N_KV_HEADS * HEAD_DIM
N_GROUPS = 8
EXPERTS_PER_GROUP = 8
N_EXPERTS = N_GROUPS * EXPERTS_PER_GROUP
TOP_K = 2
D_EXPERT = 512
MOE_BLOCK = 128
IN_SPLITS = (D_CONV, D_CONV, D_CONV, D_Q, D_KV, D_KV, D_MODEL, D_MODEL)
D_IN = D_CONV * 3 + D_Q + 2 * D_KV + 2 * D_MODEL

kernel_name = "hybrid_conv_attn_hiermoe_block"


def rmsnorm(x, g):
    xf = x.astype(jnp.float32)
    y = xf * lax.rsqrt(jnp.mean(xf * xf, axis=-1, keepdims=True) + EPS)
    return (y * g.astype(jnp.float32)).astype(x.dtype)


def split_columns(p):
    parts, off = [], 0
    for w in IN_SPLITS:
        parts.append(p[..., off:off + w])
        off += w
    return parts


def axial_rope_tables(S):
    rows = S // GRID_W
    row = jnp.repeat(jnp.arange(rows, dtype=jnp.float32), GRID_W)
    col = jnp.tile(jnp.arange(GRID_W, dtype=jnp.float32), rows)
    inv = ROPE_THETA ** (-jnp.arange(0, AXIS_DIM, 2, dtype=jnp.float32) / AXIS_DIM)
    ang = jnp.concatenate([row[:, None] * inv, col[:, None] * inv], axis=-1)
    return jnp.cos(ang), jnp.sin(ang)


def apply_rope(x, cos, sin):
    xf = x.astype(jnp.float32).reshape(*x.shape[:-1], HEAD_DIM // 2, 2)
    x0, x1 = xf[..., 0], xf[..., 1]
    c = cos[None, :, None, :]
    s = sin[None, :, None, :]
    out = jnp.stack([x0 * c - x1 * s, x0 * s + x1 * c], axis=-1)
    return out.reshape(x.shape).astype(x.dtype)


def bidirectional_gqa(q, k, v):
    B, S = q.shape[0], q.shape[1]
    G = N_HEADS // N_KV_HEADS
    nq = S // Q_BLOCK
    qb = q.reshape(B, nq, Q_BLOCK, N_KV_HEADS, G, HEAD_DIM).transpose(1, 0, 2, 3, 4, 5)

    def attend(qblk):
        s = jnp.einsum('bqkgd,bskd->bkgqs', qblk, k, preferred_element_type=jnp.float32)
        p = jax.nn.softmax(s, axis=-1)
        return jnp.einsum('bkgqs,bskd->bqkgd', p.astype(v.dtype), v)

    o = lax.map(attend, qb)
    return o.transpose(1, 0, 2, 3, 4, 5).reshape(B, S, D_Q)


def depthwise_conv_centred(z, w):
    rhs = w.reshape(CONV_WIDTH, 1, D_CONV)
    pad = (CONV_WIDTH - 1) // 2
    return lax.conv_general_dilated(z, rhs, window_strides=(1,), padding=((pad, pad),),
                                    dimension_numbers=('NWC', 'WIO', 'NWC'),
                                    feature_group_count=D_CONV)


def mixer_block(u, cos, sin, w_in, conv_w, q_norm_g, k_norm_g, w_conv_out, w_attn_out, w_o):
    B, S, _ = u.shape
    proj = u @ w_in
    cb, cc, cx, q, k, v, gc, ga = split_columns(proj)
    z = depthwise_conv_centred(cc * cx, conv_w)
    y_conv = (cb * z) @ w_conv_out
    q = rmsnorm(q.reshape(B, S, N_HEADS, HEAD_DIM), q_norm_g)
    k = rmsnorm(k.reshape(B, S, N_KV_HEADS, HEAD_DIM), k_norm_g)
    v = v.reshape(B, S, N_KV_HEADS, HEAD_DIM)
    q = apply_rope(q, cos, sin) * (HEAD_DIM ** -0.5)
    k = apply_rope(k, cos, sin)
    y_attn = bidirectional_gqa(q, k, v) @ w_attn_out
    merged = jax.nn.sigmoid(gc) * y_conv + jax.nn.sigmoid(ga) * y_attn
    return merged @ w_o


def hier_moe(u, w_group, w_router, w1, w3, w2):
    B, S, D = u.shape
    T = B * S
    hf = u.reshape(T, D)
    grp_logits = (hf @ w_group).astype(jnp.float32)
    grp_prob = jax.nn.softmax(grp_logits, axis=-1)
    g = jnp.argmax(grp_logits, axis=-1)
    pg = jnp.take_along_axis(grp_prob, g[:, None], axis=1)
    exp_logits = (hf @ w_router).astype(jnp.float32).reshape(T, N_GROUPS, EXPERTS_PER_GROUP)
    sel = jnp.take_along_axis(exp_logits, g[:, None, None], axis=1)[:, 0]
    top_v, top_i = lax.top_k(sel, TOP_K)
    weights = pg * jax.nn.softmax(top_v, axis=-1)
    expert_ids = g[:, None] * EXPERTS_PER_GROUP + top_i
    A = T * TOP_K
    e_flat = expert_ids.reshape(A).astype(jnp.int32)
    w_flat = weights.reshape(A)
    tok_flat = jnp.arange(A, dtype=jnp.int32) // TOP_K
    order = jnp.argsort(e_flat)
    se, st, sw = e_flat[order], tok_flat[order], w_flat[order]
    counts = jnp.bincount(e_flat, length=N_EXPERTS).astype(jnp.int32)
    starts = jnp.cumsum(counts) - counts
    pcounts = ((counts + MOE_BLOCK - 1) // MOE_BLOCK) * MOE_BLOCK
    pends = jnp.cumsum(pcounts)
    pstarts = pends - pcounts
    dest = pstarts[se] + (jnp.arange(A, dtype=jnp.int32) - starts[se])
    P = A + N_EXPERTS * MOE_BLOCK
    NB = P // MOE_BLOCK
    row_tok = jnp.full((P,), T, jnp.int32).at[dest].set(st)
    row_w = jnp.zeros((P,), jnp.float32).at[dest].set(sw)
    blk_expert = jnp.minimum(
        jnp.searchsorted(pends, jnp.arange(NB, dtype=jnp.int32) * MOE_BLOCK, side='right'),
        N_EXPERTS - 1).astype(jnp.int32)
    x_pad = jnp.concatenate([hf, jnp.zeros((1, D), hf.dtype)], axis=0)
    xs = x_pad[row_tok].reshape(NB, MOE_BLOCK, D)

    def expert_block(args):
        xb, e = args
        return (jax.nn.silu(xb @ w1[e]) * (xb @ w3[e])) @ w2[e]

    ys = lax.map(expert_block, (xs, blk_expert)).reshape(P, D)
    ys = ys * row_w[:, None].astype(ys.dtype)
    out = jnp.zeros((T + 1, D), ys.dtype).at[row_tok].add(ys)[:T]
    return out.reshape(B, S, D)


def setup_inputs(seed: int = 0) -> dict:
    key = jax.random.key(seed)
    ks = jax.random.split(key, 16)

    def nrm(k, shape, scale):
        return jax.random.normal(k, shape, jnp.float32) * scale

    return {
        "x": nrm(ks[0], (BATCH, SEQ, D_MODEL), 1.0),
        "norm1_g": 1.0 + nrm(ks[1], (DEPTH, D_MODEL), 0.02),
        "w_in": nrm(ks[2], (DEPTH, D_MODEL, D_IN), D_MODEL ** -0.5),
        "conv_w": nrm(ks[3], (DEPTH, CONV_WIDTH, D_CONV), CONV_WIDTH ** -0.5),
        "q_norm_g": 1.0 + nrm(ks[4], (DEPTH, HEAD_DIM), 0.02),
        "k_norm_g": 1.0 + nrm(ks[5], (DEPTH, HEAD_DIM), 0.02),
        "w_conv_out": nrm(ks[6], (DEPTH, D_CONV, D_MODEL), D_CONV ** -0.5),
        "w_attn_out": nrm(ks[7], (DEPTH, D_Q, D_MODEL), D_Q ** -0.5),
        "w_o": nrm(ks[8], (DEPTH, D_MODEL, D_MODEL), D_MODEL ** -0.5),
        "norm2_g": 1.0 + nrm(ks[9], (DEPTH, D_MODEL), 0.02),
        "w_group": nrm(ks[10], (DEPTH, D_MODEL, N_GROUPS), D_MODEL ** -0.5),
        "w_router": nrm(ks[11], (DEPTH, D_MODEL, N_EXPERTS), D_MODEL ** -0.5),
        "w1": nrm(ks[12], (DEPTH, N_EXPERTS, D_MODEL, D_EXPERT), D_MODEL ** -0.5),
        "w3": nrm(ks[13], (DEPTH, N_EXPERTS, D_MODEL, D_EXPERT), D_MODEL ** -0.5),
        "w2": nrm(ks[14], (DEPTH, N_EXPERTS, D_EXPERT, D_MODEL), D_EXPERT ** -0.5),
    }


def reference(x, norm1_g, w_in, conv_w, q_norm_g, k_norm_g, w_conv_out, w_attn_out, w_o,
              norm2_g, w_group, w_router, w1, w3, w2):
    S = x.shape[1]
    cos, sin = axial_rope_tables(S)
    h = x
    for l in range(DEPTH):
        h = h + mixer_block(rmsnorm(h, norm1_g[l]), cos, sin, w_in[l], conv_w[l],
                            q_norm_g[l], k_norm_g[l], w_conv_out[l], w_attn_out[l], w_o[l])
        h = h + hier_moe(rmsnorm(h, norm2_g[l]), w_group[l], w_router[l], w1[l], w3[l], w2[l])
    return h
```

```cpp
#include <hip/hip_runtime.h>
#include <hip/hip_bf16.h>
#include <cstdio>
#include <cstdint>

__device__ __forceinline__ void cvt8_fp8(const float (&v)[8], unsigned& w0, unsigned& w1) {
    int a = 0, b = 0; a = __builtin_amdgcn_cvt_pk_fp8_f32(v[0], v[1], a, false); a = __builtin_amdgcn_cvt_pk_fp8_f32(v[2], v[3], a, true);
    b = __builtin_amdgcn_cvt_pk_fp8_f32(v[4], v[5], b, false); b = __builtin_amdgcn_cvt_pk_fp8_f32(v[6], v[7], b, true); w0 = (unsigned)a; w1 = (unsigned)b; }
__device__ __forceinline__ void cvt8_fp8_x32(const float (&v)[8], unsigned& w0, unsigned& w1) {
    typedef short v2s_ __attribute__((ext_vector_type(2))); v2s_ a = {0, 0}, b = {0, 0};
    a = __builtin_amdgcn_cvt_scalef32_pk_fp8_f32(a, v[0], v[1], 0.03125f, false); a = __builtin_amdgcn_cvt_scalef32_pk_fp8_f32(a, v[2], v[3], 0.03125f, true);
    b = __builtin_amdgcn_cvt_scalef32_pk_fp8_f32(b, v[4], v[5], 0.03125f, false); b = __builtin_amdgcn_cvt_scalef32_pk_fp8_f32(b, v[6], v[7], 0.03125f, true);
    w0 = __builtin_bit_cast(unsigned, a); w1 = __builtin_bit_cast(unsigned, b); }
constexpr int BATCH = 4, SEQ = 4096, DM = 1024, T = BATCH * SEQ;
constexpr int NH = 8, NKV = 2, HD = 128, DKV = NKV * HD;
constexpr int DIN = 6656;
constexpr int NG = 8, EPG = 8, NE = 64, DE = 512;
constexpr int NROUTE = 72, NROUTE_PAD = 80;
constexpr int MAXTILES = 192;
constexpr float EPS = 1e-6f;

constexpr size_t MiB = 1u << 20;
constexpr size_t WS_CTL = 0, CTL_ZERO_BYTES = 160 * 1024;
constexpr size_t WS_ROPE = 1 * MiB;
constexpr size_t WS_WRT  = 1 * MiB + 64 * 1024;
constexpr size_t WS_TOK  = 2 * MiB;
constexpr size_t WS_ROWW = 3 * MiB;
constexpr size_t WS_ROWRS = 3 * MiB + 256 * 1024;
constexpr size_t WS_TRS  = 2 * MiB + 512 * 1024;
constexpr size_t WS_WIN  = 4 * MiB;
constexpr size_t WS_WC   = 18 * MiB, WS_WA = 20 * MiB, WS_WO = 22 * MiB;
constexpr size_t WS_W13  = 24 * MiB;
constexpr size_t WS_W2   = 152 * MiB;
constexpr size_t WS_R1   = 216 * MiB;
constexpr size_t SEG = 32 * MiB;
constexpr size_t WS_CB   = 248 * MiB, WS_CC = WS_CB + SEG, WS_CX = WS_CC + SEG;
constexpr size_t WS_Q    = WS_CX + SEG;
constexpr size_t WS_K    = WS_Q + SEG, WS_V = WS_K + 8 * MiB;
constexpr size_t WS_GC   = WS_V + 8 * MiB, WS_GA = WS_GC + SEG;
constexpr size_t WS_END  = WS_GA + 2 * SEG;
constexpr size_t WS_ATTO = WS_GA + SEG;
constexpr size_t WS_YCONV = WS_CC, WS_MERGED = WS_CX;
constexpr int ATTO_PM = (int)((WS_ATTO - WS_R1) / (256 * 1024 * 2));
static_assert((WS_ATTO - WS_R1) % (256 * 1024 * 2) == 0 && WS_ATTO + SEG <= 512 * MiB && WS_WC + 2 * MiB == WS_WA, "operands of the paired GEMM stream; workspace size");
constexpr size_t WS_LIST = WS_GC;
constexpr size_t WS_H    = WS_Q;
constexpr size_t WS_YS   = WS_CB;
static_assert(WS_WIN + (size_t)DIN * DM * 2 <= WS_WC && WS_W13 + (size_t)NE * 1024 * 1024 * 2 == WS_W2 && WS_W2 + (size_t)NE * 1024 * 512 * 2 == WS_R1, "ws map");
static_assert((size_t)MAXTILES * 256 * 1024 * 2 == 3 * SEG && (size_t)MAXTILES * 256 * 512 * 2 == SEG + 16 * MiB, "overlay sizes");
constexpr int CW_CNT = 16384, CNT_STRIDE = 64;
constexpr int CW_PANEL = 12288;
constexpr int CW_TILERDY = 20480;
static_assert((CW_TILERDY + 64 * MAXTILES) * 4 <= (int)CTL_ZERO_BYTES, "control words inside the per-call memset");
constexpr int CW_BAR = 4096;
static_assert((CW_CNT + 64 * CNT_STRIDE) * 4 <= (int)CTL_ZERO_BYTES && (CW_BAR + 2 * 3456) * 4 <= CW_CNT * 4, "control words inside the per-call memset");

constexpr int RING_BYTES = 131072;
constexpr int PREP_OFF = 67584, PREP_BYTES = 8192;
constexpr int LDSCTL_OFF = 135168;
static_assert(PREP_OFF + 8 * PREP_BYTES <= LDSCTL_OFF && RING_BYTES <= LDSCTL_OFF, "LDS map");
constexpr int MISC_OFF = LDSCTL_OFF + 320;
constexpr int ARGS_OFF = LDSCTL_OFF + 512;
constexpr int LDS_PSTART = LDSCTL_OFF + 1024;
constexpr int LDS_TE = LDS_PSTART + 1024;
constexpr int LDS_ROWTAB = LDS_TE + MAXTILES * 4, ROWTAB_UNITS = 8;
constexpr int LDS_BYTES = 147456;
static_assert(LDS_ROWTAB + ROWTAB_UNITS * 1024 <= LDS_BYTES, "LDS map");

namespace pg8 {
#define PG8_LAS __attribute__((address_space(3)))
typedef unsigned short bf16_t;
typedef short bf16x8 __attribute__((ext_vector_type(8)));
typedef float f32x4 __attribute__((ext_vector_type(4)));
typedef unsigned u32x4 __attribute__((ext_vector_type(4)));
constexpr int BM = 256, BK = 64, HALF = 128, HTB = HALF * BK * 2  , STAGE_BYTES = 8 * HTB, NXCD = 8, WGM = 4;

__host__ __device__ __forceinline__ int lds_byte(int r, int c) { const int st = (r >> 4) * 2 + (c >> 5), rr = r & 15, cc = c & 31, ob = rr * 64 + cc * 2; return st * 1024 + (ob ^ (((ob >> 9) & 1) << 5)); }
__host__ __device__ __forceinline__ void stage_rc(int b, int& R, int& C) { const int st = b / 1024, sb = b % 1024, swz = sb ^ (((sb >> 9) & 1) << 5); R = (st >> 1) * 16 + swz / 64; C = (st & 1) * 32 + (swz % 64) / 2; }
__host__ __device__ __forceinline__ int perm32(int rho) { const int n = rho >> 4, i = rho & 15; return 8 * (i >> 2) + 4 * n + (i & 3); }

struct Unit { int pm, pn, kind; };
struct Gemm { const bf16_t* A; const bf16_t* Bt; int M, N, K; const bf16_t* A1 = nullptr; const bf16_t* Bt1 = nullptr; int K1 = 0; };

struct StaticOrder {
    int nM, nN, nwg, G, c, reps;
    __host__ __device__ void init(int M, int N, int G_, int c_, int reps_ = 1) { nM = M / BM; nN = N / BM; nwg = nM * nN; G = G_; c = c_; reps = reps_; }
    __host__ __device__ bool next(int i, Unit& u) const {
        const long L = (long)i * G + c; if (L >= (long)nwg * reps) return false;
        int wgid = (int)(L % nwg); { const int q = nwg / NXCD, r = nwg % NXCD, xcd = wgid % NXCD, off = wgid / NXCD; wgid = (xcd < r ? xcd * (q + 1) : r * (q + 1) + (xcd - r) * q) + off; }
        const int nig = WGM * nN, gid = wgid / nig, fm = gid * WGM, gsz = (nM - fm) < WGM ? (nM - fm) : WGM;
        u.pm = fm + ((wgid % nig) % gsz); u.pn = (wgid % nig) / gsz; u.kind = 0; return true;
    }
    __device__ __forceinline__ void a_ready(const Unit&) const {}
    __device__ __forceinline__ void done(const Unit&) const {}
};

__device__ __forceinline__ unsigned cvt_pk_bf16(float lo, float hi) { unsigned r; asm volatile("v_cvt_pk_bf16_f32 %0, %1, %2" : "=v"(r) : "v"(lo), "v"(hi)); return r; }
__device__ __forceinline__ float bf_lo(unsigned w) { return __uint_as_float(w << 16); }
__device__ __forceinline__ float bf_hi(unsigned w) { return __uint_as_float(w & 0xffff0000u); }
__device__ __forceinline__ float sigmoidf_(float x) { return __builtin_amdgcn_rcpf(1.0f + __expf(-x)); }
__device__ __forceinline__ u32x4 pack8(const f32x4 v0, const f32x4 v1) { u32x4 w; w.x = cvt_pk_bf16(v0[0], v0[1]); w.y = cvt_pk_bf16(v0[2], v0[3]); w.z = cvt_pk_bf16(v1[0], v1[1]); w.w = cvt_pk_bf16(v1[2], v1[3]); return w; }

__device__ __forceinline__ void st8_wt(void* p, unsigned w0, unsigned w1) { typedef unsigned u32x2_ __attribute__((ext_vector_type(2))); const u32x2_ v = {w0, w1}; asm volatile("global_store_dwordx2 %0, %1, off sc1\n\ts_nop 1" :: "v"(p), "v"(v) : "memory"); }
__device__ __forceinline__ void st16_wt(void* p, const u32x4 v) { asm volatile("global_store_dwordx4 %0, %1, off sc1\n\ts_nop 1" :: "v"(p), "v"(v) : "memory"); }
struct EpiPlain {
    static constexpr bool PERM = true, AFTER_DRAIN = false;
    bf16_t* O; int ldc;
    __device__ __forceinline__ void operator()(const f32x4 (&acc)[2][2][4][2], const Unit& u, int wr, int wc, int fr, int fq) const {
        const int row0 = u.pm * BM + wr * 64 + fr, col0 = u.pn * BM + wc * 32 + 8 * fq;
#pragma unroll
        for (int ai = 0; ai < 2; ++ai)
#pragma unroll
            for (int m = 0; m < 4; ++m) { bf16_t* rowp = O + (size_t)(row0 + ai * HALF + m * 16) * ldc + col0;
#pragma unroll
                for (int bj = 0; bj < 2; ++bj) *(u32x4*)(rowp + bj * HALF) = pack8(acc[ai][bj][m][0], acc[ai][bj][m][1]); }
    }
};
struct EpiProj {
    static constexpr bool PERM = true, AFTER_DRAIN = false;
    unsigned char* ws; const float* qg; const float* kg; PG8_LAS float* xch;
    __device__ __forceinline__ void operator()(const f32x4 (&acc)[2][2][4][2], const Unit& u, int wr, int wc, int fr, int fq) const {
        const int pn = u.pn; size_t off; int ldc, colt; bool sig = false;
        if (pn < 12)       { off = WS_CB + (size_t)(pn >> 2) * SEG; ldc = 1024; colt = (pn & 3) * 256; }
        else if (pn < 16)  { off = WS_Q; ldc = 1024; colt = (pn - 12) * 256; }
        else if (pn == 16) { off = WS_K; ldc = 256; colt = 0; }
        else if (pn == 17) { off = WS_V; ldc = 256; colt = 0; }
        else               { off = WS_GC + (size_t)((pn - 18) >> 2) * SEG; ldc = 1024; colt = ((pn - 18) & 3) * 256; sig = true; }
        bf16_t* base = (bf16_t*)(ws + off);
        const int row0 = u.pm * BM + wr * 64 + fr, col0 = colt + wc * 32 + 8 * fq;
        if (pn >= 4 && pn < 12) {
            bf16_t* P = (bf16_t*)(ws + WS_CC); const int pc0 = (pn - 4) * 128 + wc * 32 + 8 * fq;
#pragma unroll
            for (int ai = 0; ai < 2; ++ai)
#pragma unroll
                for (int m = 0; m < 4; ++m) *(u32x4*)(P + (size_t)(row0 + ai * HALF + m * 16) * 1024 + pc0) = pack8(acc[ai][0][m][0] * acc[ai][1][m][0], acc[ai][0][m][1] * acc[ai][1][m][1]);
            return;
        }
        if (pn >= 12 && pn <= 16) {
#pragma unroll
            for (int ai = 0; ai < 2; ++ai)
#pragma unroll
                for (int m = 0; m < 4; ++m)
#pragma unroll
                    for (int bj = 0; bj < 2; ++bj) { const f32x4 a = acc[ai][bj][m][0], b = acc[ai][bj][m][1];
                        float s = (a[0] * a[0] + a[1] * a[1]) + (a[2] * a[2] + a[3] * a[3]) + (b[0] * b[0] + b[1] * b[1]) + (b[2] * b[2] + b[3] * b[3]);
                        s += __shfl_xor(s, 16); s += __shfl_xor(s, 32);
                        if (fq == 0) xch[((ai * HALF + wr * 64 + m * 16 + fr) * 2 + bj) * 4 + wc] = s; }
            asm volatile("s_waitcnt lgkmcnt(0)" ::: "memory"); __builtin_amdgcn_s_barrier(); asm volatile("" ::: "memory");
            const float* gam = (pn == 16 ? kg : qg) + wc * 32 + 8 * fq;
            const f32x4 g0 = *(const f32x4*)gam, g1 = *(const f32x4*)(gam + 4);
            const float* ct = (const float*)(ws + WS_ROPE); const float* st = ct + 2048; const int j0 = 16 * (wc & 1) + 4 * fq;
#pragma unroll
            for (int ai = 0; ai < 2; ++ai)
#pragma unroll
                for (int m = 0; m < 4; ++m) { const int rl = ai * HALF + wr * 64 + m * 16 + fr, r = u.pm * BM + rl, sq = r & (SEQ - 1), pos = (wc < 2) ? (sq >> 6) : (sq & 63);
                    const f32x4 c4 = *(const f32x4*)(ct + pos * 32 + j0), s4 = *(const f32x4*)(st + pos * 32 + j0);
                    bf16_t* rowp = base + (size_t)r * ldc + col0;
#pragma unroll
                    for (int bj = 0; bj < 2; ++bj) { const f32x4 p = *(const PG8_LAS f32x4*)(xch + (rl * 2 + bj) * 4);
                        const float rstd = 1.f / sqrtf(((p[0] + p[1]) + (p[2] + p[3])) * (1.f / 128.f) + EPS);
                        const f32x4 y0 = acc[ai][bj][m][0] * rstd * g0, y1 = acc[ai][bj][m][1] * rstd * g1; f32x4 o0, o1;
                        o0[0] = y0[0] * c4[0] - y0[1] * s4[0]; o0[1] = y0[0] * s4[0] + y0[1] * c4[0]; o0[2] = y0[2] * c4[1] - y0[3] * s4[1]; o0[3] = y0[2] * s4[1] + y0[3] * c4[1];
                        o1[0] = y1[0] * c4[2] - y1[1] * s4[2]; o1[1] = y1[0] * s4[2] + y1[1] * c4[2]; o1[2] = y1[2] * c4[3] - y1[3] * s4[3]; o1[3] = y1[2] * s4[3] + y1[3] * c4[3];
                        *(u32x4*)(rowp + bj * HALF) = pack8(o0, o1); } }
            return;
        }
#pragma unroll
        for (int ai = 0; ai < 2; ++ai)
#pragma unroll
            for (int m = 0; m < 4; ++m) { bf16_t* rowp = base + (size_t)(row0 + ai * HALF + m * 16) * ldc + col0;
#pragma unroll
                for (int bj = 0; bj < 2; ++bj) { f32x4 v0 = acc[ai][bj][m][0], v1 = acc[ai][bj][m][1];
                    if (sig) {
#pragma unroll
                        for (int i = 0; i < 4; ++i) { v0[i] = sigmoidf_(v0[i]); v1[i] = sigmoidf_(v1[i]); } }
                    *(u32x4*)(rowp + bj * HALF) = pack8(v0, v1); } }
    }
};
struct EpiMerge {
    static constexpr bool PERM = true, AFTER_DRAIN = false;
    const bf16_t* gc; const bf16_t* ga; const bf16_t* yc; bf16_t* O;
    __device__ __forceinline__ void operator()(const f32x4 (&acc)[2][2][4][2], const Unit& u, int wr, int wc, int fr, int fq) const {
        const int row0 = u.pm * BM + wr * 64 + fr, col0 = u.pn * BM + wc * 32 + 8 * fq;
        constexpr int RB = 2;
#pragma unroll
        for (int ai = 0; ai < 2; ++ai)
#pragma unroll
            for (int mb = 0; mb < 4; mb += RB) {
                u32x4 g1[RB][2], g2[RB][2], y[RB][2];
#pragma unroll
                for (int mm = 0; mm < RB; ++mm)
#pragma unroll
                    for (int bj = 0; bj < 2; ++bj) { const size_t o = (size_t)(row0 + ai * HALF + (mb + mm) * 16) * 1024 + col0 + bj * HALF;
                        g1[mm][bj] = *(const u32x4*)(gc + o); g2[mm][bj] = *(const u32x4*)(ga + o); y[mm][bj] = *(const u32x4*)(yc + o); }
#pragma unroll
                for (int mm = 0; mm < RB; ++mm)
#pragma unroll
                    for (int bj = 0; bj < 2; ++bj) { const int m = mb + mm; const size_t o = (size_t)(row0 + ai * HALF + m * 16) * 1024 + col0 + bj * HALF;
                        const u32x4 a = g1[mm][bj], b = g2[mm][bj], c = y[mm][bj]; const f32x4 a0 = acc[ai][bj][m][0], a1 = acc[ai][bj][m][1]; f32x4 r0, r1;
                        r0[0] = bf_lo(a.x) * bf_lo(c.x) + bf_lo(b.x) * a0[0]; r0[1] = bf_hi(a.x) * bf_hi(c.x) + bf_hi(b.x) * a0[1];
                        r0[2] = bf_lo(a.y) * bf_lo(c.y) + bf_lo(b.y) * a0[2]; r0[3] = bf_hi(a.y) * bf_hi(c.y) + bf_hi(b.y) * a0[3];
                        r1[0] = bf_lo(a.z) * bf_lo(c.z) + bf_lo(b.z) * a1[0]; r1[1] = bf_hi(a.z) * bf_hi(c.z) + bf_hi(b.z) * a1[1];
                        r1[2] = bf_lo(a.w) * bf_lo(c.w) + bf_lo(b.w) * a1[2]; r1[3] = bf_hi(a.w) * bf_hi(c.w) + bf_hi(b.w) * a1[3];
                        *(u32x4*)(O + o) = pack8(r0, r1); }
                asm volatile("" ::: "memory"); }
    }
};
struct EpiPair {
    static constexpr bool PERM = true, AFTER_DRAIN = false;
    EpiPlain conv; EpiMerge mrg;
    __device__ __forceinline__ void operator()(const f32x4 (&acc)[2][2][4][2], const Unit& u, int wr, int wc, int fr, int fq) const {
        if (u.pn < 4) conv(acc, u, wr, wc, fr, fq);
        else { Unit v; v.pm = u.pm - ATTO_PM; v.pn = u.pn - 4; v.kind = 0; mrg(acc, v, wr, wc, fr, fq); }
    }
};
struct PairOrder {
    StaticOrder so;
    __device__ __forceinline__ bool next(int i, Unit& u) const { if (!so.next(i >> 1, u)) return false; const int st = i & 1; u.pm += ATTO_PM * st; u.pn += 4 * st; return true; }
    __device__ __forceinline__ void a_ready(const Unit&) const {}
    __device__ __forceinline__ void done(const Unit&) const {}
};
struct EpiResid {
    static constexpr bool PERM = false, AFTER_DRAIN = false;
    const float* x; float* out; bool wt;
    __device__ __forceinline__ void operator()(const f32x4 (&acc)[2][2][4][2], const Unit& u, int wr, int wc, int fr, int fq) const {
        const int row0 = u.pm * BM + wr * 64 + fr, col0 = u.pn * BM + wc * 32 + 4 * fq;
        constexpr int RB = 4;
#pragma unroll
        for (int ai = 0; ai < 2; ++ai)
#pragma unroll
            for (int mb = 0; mb < 4; mb += RB) {
                f32x4 xv[RB][2][2];
#pragma unroll
                for (int mm = 0; mm < RB; ++mm)
#pragma unroll
                    for (int bj = 0; bj < 2; ++bj)
#pragma unroll
                        for (int n = 0; n < 2; ++n) xv[mm][bj][n] = *(const f32x4*)(x + (size_t)(row0 + ai * HALF + (mb + mm) * 16) * 1024 + col0 + bj * HALF + n * 16);
#pragma unroll
                for (int mm = 0; mm < RB; ++mm)
#pragma unroll
                    for (int bj = 0; bj < 2; ++bj)
#pragma unroll
                        for (int n = 0; n < 2; ++n) { const f32x4 r_ = xv[mm][bj][n] + acc[ai][bj][mb + mm][n]; float* q_ = out + (size_t)(row0 + ai * HALF + (mb + mm) * 16) * 1024 + col0 + bj * HALF + n * 16;
                            if (wt) st16_wt(q_, __builtin_bit_cast(u32x4, r_)); else *(f32x4*)q_ = r_; }
                asm volatile("" ::: "memory"); }
    }
};
struct EpiSwiGLU {
    static constexpr bool PERM = true, AFTER_DRAIN = false;
    bf16_t* H; const unsigned* lst; const PG8_LAS int* ps; bool wt;
    __device__ __forceinline__ void operator()(const f32x4 (&acc)[2][2][4][2], const Unit& u, int wr, int wc, int fr, int fq) const {
        const int row0 = u.pm * BM + wr * 64 + fr, col0 = (u.pn & 3) * 128 + wc * 32 + 8 * fq; const int e = u.pn >> 2;
        const unsigned* le = lst + ((size_t)e * T + (size_t)(row0 - ps[e])) * 4 + 2;
#pragma unroll
        for (int ai = 0; ai < 2; ++ai)
#pragma unroll
            for (int m = 0; m < 4; ++m) { unsigned char* rowp = (unsigned char*)H + (size_t)(row0 + ai * HALF + m * 16) * 512 + col0; const float rs = __uint_as_float(le[(ai * HALF + m * 16) * 4]) * 0.03125f;
                f32x4 h0, h1;
#pragma unroll
                for (int i = 0; i < 4; ++i) { const float a = acc[ai][0][m][0][i] * rs, b = acc[ai][1][m][0][i] * rs, c = acc[ai][0][m][1][i] * rs, d = acc[ai][1][m][1][i] * rs;
                    h0[i] = a * sigmoidf_(a) * b; h1[i] = c * sigmoidf_(c) * d; }
                const float hv[8] = {h0[0], h0[1], h0[2], h0[3], h1[0], h1[1], h1[2], h1[3]}; unsigned w0, w1; cvt8_fp8(hv, w0, w1);
                if (wt) st8_wt(rowp, w0, w1); else { typedef unsigned u32x2_ __attribute__((ext_vector_type(2))); const u32x2_ v2 = {w0, w1}; *(u32x2_*)rowp = v2; } }
    }
};
struct EpiMoeOut {
    static constexpr bool PERM = true, AFTER_DRAIN = false;
    const unsigned* lst; const PG8_LAS int* ps; bf16_t* YS;
    __device__ __forceinline__ void operator()(const f32x4 (&acc)[2][2][4][2], const Unit& u, int wr, int wc, int fr, int fq) const {
        const int row0 = u.pm * BM + wr * 64 + fr, col0 = (u.pn & 3) * 256 + wc * 32 + 8 * fq; const int e = u.pn >> 2;
        const unsigned* le = lst + ((size_t)e * T + (size_t)(row0 - ps[e])) * 4 + 1;
#pragma unroll
        for (int ai = 0; ai < 2; ++ai)
#pragma unroll
            for (int m = 0; m < 4; ++m) { const int r = row0 + ai * HALF + m * 16; const float w = __uint_as_float(le[(ai * HALF + m * 16) * 4]) * 0.5f; unsigned char* rowp = (unsigned char*)YS + (size_t)r * 1024 + col0;
#pragma unroll
                for (int bj = 0; bj < 2; ++bj) { const f32x4 a0 = acc[ai][bj][m][0] * w, a1 = acc[ai][bj][m][1] * w; const float yv[8] = {a0[0], a0[1], a0[2], a0[3], a1[0], a1[1], a1[2], a1[3]};
                    unsigned w0, w1; cvt8_fp8(yv, w0, w1); typedef unsigned u32x2_ __attribute__((ext_vector_type(2))); const u32x2_ v2 = {w0, w1}; *(u32x2_*)(rowp + bj * HALF) = v2; } }
    }
};
struct MoeOrder {
    int nunits, G, c; const PG8_LAS int* te; int reps; int i0, imax;
    __device__ __forceinline__ bool next(int i, Unit& u) const {
        if (i >= imax) return false;
        int L = (i + i0) * G + c; if (L >= nunits * reps) return false; L %= nunits;
        const int tile = L >> 2; u.pm = tile; u.pn = te[tile] * 4 + (L & 3); u.kind = 0; return true; }
    __device__ __forceinline__ void a_ready(const Unit&) const {}
    __device__ __forceinline__ void done(const Unit&) const {}
};

struct ChainOrder {
    int nt, G, c; const PG8_LAS int* te; unsigned* ready; unsigned* tmo;
    __device__ __forceinline__ int su(int g) const { const int r = nt - 64 * g; return 4 * (r > 64 ? 64 : r); }
    __device__ __forceinline__ void mk(Unit& u, int g, int q, int kind) const { const int tile = 64 * g + (q >> 2); u.pm = tile; u.pn = te[tile] * 4 + (q & 3); u.kind = kind; }
    __device__ __forceinline__ bool decode(int pos, Unit& u) const {
        const int ng = (nt + 63) >> 6;
        if (pos < su(0)) { mk(u, 0, pos, 0); return true; } pos -= su(0);
        for (int g = 1; g < ng; ++g) { if (pos < su(g)) { mk(u, g, pos, 0); return true; } pos -= su(g); if (pos < su(g - 1)) { mk(u, g - 1, pos, 1); return true; } pos -= su(g - 1); }
        if (pos < su(ng - 1)) { mk(u, ng - 1, pos, 1); return true; }
        return false; }
    __device__ __forceinline__ bool next(int i, Unit& u) const {
        if (mode == 0) return decode(i * G + c, u);
        if (i >= imax) return false;
        const int L = (i + i0) * G + c; if (L >= nt * 4) return false;
        const int tile = L >> 2; u.pm = tile; u.pn = te[tile] * 4 + (L & 3); u.kind = mode - 1; return true; }
    __device__ __forceinline__ void a_ready(const Unit& u) const {
        if (u.kind != 1 || mode != 0) return;
        int l; asm volatile("v_mbcnt_lo_u32_b32 %0, -1, 0\n\tv_mbcnt_hi_u32_b32 %0, -1, %0" : "=v"(l));
        if (__builtin_amdgcn_readfirstlane(l) == 0 && wave0) {
            unsigned sp = 0; while ((unsigned)__builtin_amdgcn_readfirstlane(__hip_atomic_load(ready + 64 * u.pm, __ATOMIC_RELAXED, __HIP_MEMORY_SCOPE_AGENT)) < 32u) { __builtin_amdgcn_s_sleep(2); if (++sp > (1u << 22)) { if (l == 0) __hip_atomic_store(tmo, 1u, __ATOMIC_RELAXED, __HIP_MEMORY_SCOPE_AGENT); break; } }
            asm volatile("s_waitcnt vmcnt(0)" ::: "memory"); }
        asm volatile("" ::: "memory"); __builtin_amdgcn_s_barrier(); asm volatile("" ::: "memory");
    }
    __device__ __forceinline__ void done(const Unit& u) const {
        if (u.kind != 0 || mode != 0) return;
        asm volatile("s_waitcnt vmcnt(0)" ::: "memory");
        int l; asm volatile("v_mbcnt_lo_u32_b32 %0, -1, 0\n\tv_mbcnt_hi_u32_b32 %0, -1, %0" : "=v"(l));
        if (l == 0) (void)__hip_atomic_fetch_add(ready + 64 * u.pm, 1u, __ATOMIC_RELAXED, __HIP_MEMORY_SCOPE_AGENT); }
    bool wave0; int mode = 0, i0 = 0, imax = 1 << 30;
};
struct EpiChain {
    static constexpr bool PERM = true, AFTER_DRAIN = false;
    EpiSwiGLU up; EpiMoeOut down;
    __device__ __forceinline__ void operator()(const f32x4 (&acc)[2][2][4][2], const Unit& u, int wr, int wc, int fr, int fq) const { if (u.kind == 0) up(acc, u, wr, wc, fr, fq); else down(acc, u, wr, wc, fr, fq); }
};

template <class Epi, class Sched, bool ALIGN_EPI = false, bool SP2 = false, bool GATHER = false, bool HET = false, bool FP8 = false>
__device__ __forceinline__ void gemm_phase(PG8_LAS unsigned char* lds, const Gemm g, const Sched& S, const Epi& E, int wave_, const PG8_LAS unsigned* rowtab = nullptr) {
    int lane; asm volatile("v_mbcnt_lo_u32_b32 %0, -1, 0\n\tv_mbcnt_hi_u32_b32 %0, -1, %0" : "=v"(lane));
    const int wid = wave_, tid = wid * 64 + lane, wr = wid >> 2, wc = wid & 3, fr = lane & 15, fq = lane >> 4;
    const int K = g.K, nt = K / BK;
    unsigned voffA[2], voffB[2]; int gR[2], gRb[2]; unsigned gC2[2];
#pragma unroll
    for (int i = 0; i < 2; ++i) { int R, C; stage_rc(tid * 16 + i * 8192, R, C); const int Rb = Epi::PERM ? ((R & ~31) + perm32(R & 31)) : R;
        voffA[i] = (unsigned)(R * K + C) * 2u; voffB[i] = (unsigned)(Rb * K + C) * 2u; gR[i] = R; gC2[i] = (unsigned)C * 2u; gRb[i] = Rb; }
    const size_t kstep = (size_t)(BK * 2);
    const size_t hstep = (size_t)HALF * K * 2;
    const size_t tstep = 2 * hstep;
    const unsigned ldsw = (unsigned)wid * 1024u;
    const unsigned ldsb = (unsigned)(size_t)lds + ldsw;
    const int aoff = lds_byte(wr * 64 + fr, fq * 8), boff = lds_byte(wc * 32 + fr, fq * 8);
#define PG8_SA(b, h) (((b) * 2 + (h)) * HTB)
#define PG8_SB(b, h) ((4 + (b) * 2 + (h)) * HTB)
#define PG8_STAGE(bufoff, gbase, voff) do { _Pragma("unroll") for (int _i = 0; _i < 2; ++_i) PG8_GLDS_S(gbase, (voff)[_i], ldsb + (unsigned)((bufoff) + _i * 8192)); } while (0)
#define PG8_GLDS_S(sbase, voff32, ldsaddr) do { asm volatile("s_mov_b32 m0, %2\n\ts_nop 0\n\tglobal_load_lds_dwordx4 %0, %1" :: "v"(voff32), "s"((const char*)(sbase)), "s"(ldsaddr) : "memory"); } while (0)
#define PG8_GLDS_S1(sbase, voff32, ldsaddr) do { asm volatile("s_mov_b32 m0, %2\n\ts_nop 0\n\tglobal_load_lds_dwordx4 %0, %1 sc1" :: "v"(voff32), "s"((const char*)(sbase)), "s"(ldsaddr) : "memory"); } while (0)
#define PG8_KSEL_vc0 kc1
#define PG8_KSEL_w0 kw1
#define PG8_STAGE_A(bufoff, ptr, h, vsel0, vsel1) do { if constexpr (FP8) { if (PG8_KSEL_##vsel0) { _Pragma("unroll") for (int _i = 0; _i < 2; ++_i) PG8_GLDS_S1(ptr, ((h) == 0 ? vc0[_i] : vc1[_i]), ldsb + (unsigned)((bufoff) + _i * 8192)); } \
        else { _Pragma("unroll") for (int _i = 0; _i < 2; ++_i) PG8_GLDS_S(ptr, ((h) == 0 ? vc0[_i] : vc1[_i]), ldsb + (unsigned)((bufoff) + _i * 8192)); } } else if constexpr (GATHER) { if ((h) == 0) PG8_STAGE(bufoff, ptr, vsel0); else PG8_STAGE(bufoff, ptr, vsel1); } else { PG8_STAGE(bufoff, (ptr) + (h) * hstep, voffA); } } while (0)
#define PG8_STAGE_B(bufoff, ptr, h, NEXT) do { if constexpr (FP8) { const unsigned p_ = (NEXT) ? pw : pc; const unsigned vo_ = (unsigned)gRb[0] * p_ + gC2[0];   \
        _Pragma("unroll") for (int _i = 0; _i < 2; ++_i) PG8_GLDS_S((ptr) + (size_t)(((h) * 2 + _i) * 64) * p_, vo_, ldsb + (unsigned)((bufoff) + _i * 8192)); } else if constexpr (HET) { if (NEXT) PG8_STAGE(bufoff, (ptr) + (h) * hsw, wb); else PG8_STAGE(bufoff, (ptr) + (h) * hs, vb); } else { PG8_STAGE(bufoff, (ptr) + (h) * hstep, voffB); } } while (0)
#define PG8_LDA(dst, b, h) do { _Pragma("unroll") for (int m = 0; m < 4; ++m) _Pragma("unroll") for (int k = 0; k < 2; ++k) dst[m][k] = *(const PG8_LAS bf16x8*)(lds + PG8_SA(b, h) + aoff + m * 2048 + k * 1024); } while (0)
#define PG8_LDB(dst, b, h) do { _Pragma("unroll") for (int n = 0; n < 2; ++n) _Pragma("unroll") for (int k = 0; k < 2; ++k) dst[n][k] = *(const PG8_LAS bf16x8*)(lds + PG8_SB(b, h) + boff + n * 2048 + k * 1024); } while (0)
#define PG8_MMA(ai, bj, At, Bt) do { __builtin_amdgcn_s_setprio(1); _Pragma("unroll") for (int m = 0; m < 4; ++m) _Pragma("unroll") for (int n = 0; n < 2; ++n) { \
        if constexpr (FP8) { typedef int v8i_ __attribute__((ext_vector_type(8))); typedef int v4i_ __attribute__((ext_vector_type(4))); \
            const v4i_ b0_ = __builtin_bit_cast(v4i_, Bt[n][0]), b1_ = __builtin_bit_cast(v4i_, Bt[n][1]), a0_ = __builtin_bit_cast(v4i_, At[m][0]), a1_ = __builtin_bit_cast(v4i_, At[m][1]); \
            const v8i_ bb_ = {b0_[0], b0_[1], b0_[2], b0_[3], b1_[0], b1_[1], b1_[2], b1_[3]}, aa_ = {a0_[0], a0_[1], a0_[2], a0_[3], a1_[0], a1_[1], a1_[2], a1_[3]}; \
            acc[ai][bj][m][n] = __builtin_amdgcn_mfma_scale_f32_16x16x128_f8f6f4(bb_, aa_, acc[ai][bj][m][n], 0, 0, 0, 0, 0, 0); } \
        else { _Pragma("unroll") for (int k = 0; k < 2; ++k) acc[ai][bj][m][n] = __builtin_amdgcn_mfma_f32_16x16x32_bf16(Bt[n][k], At[m][k], acc[ai][bj][m][n], 0, 0, 0); } } \
        __builtin_amdgcn_s_setprio(0); } while (0)
#define PG8_WAIT_V(n) asm volatile("s_waitcnt vmcnt(" #n ")" ::: "memory")
#define PG8_WAIT_L(n) asm volatile("s_waitcnt lgkmcnt(" #n ")" ::: "memory")
#define PG8_BAR __builtin_amdgcn_s_barrier()
#define PG8_SCHED __builtin_amdgcn_sched_barrier(0)
    Unit cur, nxt; int ui = 0;
    if (!S.next(0, cur)) return;
    f32x4 acc[2][2][4][2];
#pragma unroll
    for (int a = 0; a < 2; ++a)
#pragma unroll
        for (int b = 0; b < 2; ++b)
#pragma unroll
            for (int m = 0; m < 4; ++m)
#pragma unroll
                for (int n = 0; n < 2; ++n) acc[a][b][m][n] = (f32x4){0.f, 0.f, 0.f, 0.f};
    bf16x8 At[4][2], B0[2][2], B1[2][2];
    unsigned vb[2] = {voffB[0], voffB[1]}, vbn[2] = {voffB[0], voffB[1]}, wb[2] = {voffB[0], voffB[1]}; size_t hs = hstep, hsn = hstep, hsw = hstep; int ntc = nt;
    auto kK = [&](int kind) { return kind ? g.K1 : g.K; };
    static_assert(!FP8 || (SP2 && GATHER && HET), "the FP8 form is written for the gathered heterogeneous stream");
    unsigned pc = (unsigned)g.K * 2u, pn = pc, pw = pc;
    bool kc1 = false, kw1 = false; (void)kc1; (void)kw1;
    if constexpr (FP8) { pc = (unsigned)kK(cur.kind) * 2u; pn = pc; pw = pc; hs = (size_t)HALF * pc; hsn = hs; ntc = kK(cur.kind) / BK; kc1 = cur.kind == 1; kw1 = kc1; }
    if constexpr (HET && !FP8) {
#pragma unroll
        for (int i = 0; i < 2; ++i) { vb[i] = (unsigned)(gRb[i] * kK(cur.kind)) * 2u + gC2[i]; vbn[i] = vb[i]; }
        hs = (size_t)HALF * kK(cur.kind) * 2; hsn = hs; ntc = kK(cur.kind) / BK; }
    const char* cA = HET ? (const char*)(cur.kind ? g.A1 : g.A) : (const char*)g.A + (GATHER ? (size_t)0 : (size_t)cur.pm * tstep);
    const char* cB = HET ? (const char*)(cur.kind ? g.Bt1 : g.Bt) + (size_t)cur.pn * (2 * hs) : (const char*)g.Bt + (size_t)cur.pn * tstep;
    unsigned vc0[2] = {0u, 0u}, vc1[2] = {0u, 0u}, vn0[2] = {0u, 0u}, vn1[2] = {0u, 0u};
    if constexpr (GATHER) {
#pragma unroll
        for (int i = 0; i < 2; ++i) { vc0[i] = rowtab[gR[i]] + gC2[i]; vc1[i] = rowtab[HALF + gR[i]] + gC2[i]; vn0[i] = vc0[i]; vn1[i] = vc1[i]; } }
    S.a_ready(cur);
    if constexpr (SP2) {
        PG8_STAGE_B(PG8_SB(0, 0), cB, 0, false); PG8_STAGE_B(PG8_SB(0, 1), cB, 1, false); PG8_STAGE_A(PG8_SA(0, 0), cA, 0, vc0, vc1); PG8_STAGE_A(PG8_SA(0, 1), cA, 1, vc0, vc1);
        if (wr == 1) PG8_BAR;
        PG8_WAIT_V(2); PG8_BAR;
        PG8_STAGE_B(PG8_SB(1, 0), cB + kstep, 0, false); PG8_STAGE_A(PG8_SA(1, 0), cA + kstep, 0, vc0, vc1); PG8_STAGE_B(PG8_SB(1, 1), cB + kstep, 1, false);
        PG8_WAIT_V(6); PG8_BAR;
    } else {
        PG8_STAGE_B(PG8_SB(0, 0), cB, 0, false); PG8_STAGE_A(PG8_SA(0, 0), cA, 0, vc0, vc1); PG8_STAGE_B(PG8_SB(0, 1), cB, 1, false); PG8_STAGE_A(PG8_SA(0, 1), cA, 1, vc0, vc1);
        if (wr == 1) PG8_BAR;
        PG8_WAIT_V(4); PG8_BAR;
        PG8_STAGE_B(PG8_SB(1, 0), cB + kstep, 0, false); PG8_STAGE_A(PG8_SA(1, 0), cA + kstep, 0, vc0, vc1); PG8_STAGE_B(PG8_SB(1, 1), cB + kstep, 1, false);
        PG8_WAIT_V(6); PG8_BAR;
    }
    for (;;) {
        const bool has_next = S.next(ui + 1, nxt);
        if constexpr (FP8) { pn = has_next ? (unsigned)kK(nxt.kind) * 2u : pc; hsn = (size_t)HALF * pn; }
        if constexpr (HET && !FP8) { if (has_next) {
#pragma unroll
                for (int i = 0; i < 2; ++i) vbn[i] = (unsigned)(gRb[i] * kK(nxt.kind)) * 2u + gC2[i];
                hsn = (size_t)HALF * kK(nxt.kind) * 2; } else { vbn[0] = vb[0]; vbn[1] = vb[1]; hsn = hs; } }
        const char* nA = HET ? (has_next ? (const char*)(nxt.kind ? g.A1 : g.A) : cA) : ((has_next && !GATHER) ? (const char*)g.A + (size_t)nxt.pm * tstep : cA);
        const char* nB = HET ? (has_next ? (const char*)(nxt.kind ? g.Bt1 : g.Bt) + (size_t)nxt.pn * (2 * hsn) : cB) : (has_next ? (const char*)g.Bt + (size_t)nxt.pn * tstep : cB);
        for (int t = 0; t < ntc; t += 2) {
            const bool last = (t == ntc - 2);
            const char* a1 = cA + (size_t)(t + 1) * kstep;
            const char* a2 = last ? nA : cA + (size_t)(t + 2) * kstep; const char* b2 = last ? nB : cB + (size_t)(t + 2) * kstep;
            const char* a3 = a2 + kstep; const char* b3 = b2 + kstep;
            if (last && has_next) S.a_ready(nxt);
            unsigned w0[2] = {0u, 0u}, w1[2] = {0u, 0u};
            if constexpr (FP8) { pw = last ? pn : pc; kw1 = (last && has_next) ? (nxt.kind == 1) : kc1;
                if (last && has_next) {
#pragma unroll
                    for (int i = 0; i < 2; ++i) vc0[i] = rowtab[(ui + 1) * BM + gR[0] + 64 * i] + gC2[0]; } }
            if constexpr (HET && !FP8) { wb[0] = last ? vbn[0] : vb[0]; wb[1] = last ? vbn[1] : vb[1]; hsw = last ? hsn : hs; }
            if constexpr (GATHER && !FP8) {
                if (last && has_next) {
#pragma unroll
                    for (int i = 0; i < 2; ++i) { vn0[i] = rowtab[(ui + 1) * BM + gR[i]] + gC2[i]; vn1[i] = rowtab[(ui + 1) * BM + HALF + gR[i]] + gC2[i]; } }
#pragma unroll
                for (int i = 0; i < 2; ++i) { w0[i] = last ? vn0[i] : vc0[i]; w1[i] = last ? vn1[i] : vc1[i]; } }
            if constexpr (SP2) {
            PG8_LDB(B0, 0, 0); PG8_LDB(B1, 0, 1); PG8_SCHED; PG8_LDA(At, 0, 0); PG8_STAGE_A(PG8_SA(1, 1), a1, 1, vc0, vc1);
            if constexpr (FP8) { if (last && has_next) {
#pragma unroll
                    for (int i = 0; i < 2; ++i) vc1[i] = rowtab[(ui + 1) * BM + HALF + gR[0] + 64 * i] + gC2[0]; } }
            PG8_WAIT_V(8); PG8_WAIT_L(0); PG8_BAR; PG8_MMA(0, 0, At, B0); PG8_MMA(0, 1, At, B1); PG8_BAR; PG8_SCHED;
            PG8_LDA(At, 0, 1); PG8_STAGE_B(PG8_SB(0, 0), b2, 0, true); PG8_STAGE_B(PG8_SB(0, 1), b2, 1, true); PG8_STAGE_A(PG8_SA(0, 0), a2, 0, w0, w1);
            PG8_WAIT_V(8); PG8_WAIT_L(0); PG8_BAR; PG8_MMA(1, 0, At, B0); PG8_MMA(1, 1, At, B1); PG8_BAR; PG8_SCHED;
            PG8_LDB(B0, 1, 0); PG8_LDB(B1, 1, 1); PG8_SCHED; PG8_LDA(At, 1, 0); PG8_STAGE_A(PG8_SA(0, 1), a2, 1, w0, w1);
            PG8_WAIT_V(8); PG8_WAIT_L(0); PG8_BAR; PG8_MMA(0, 0, At, B0); PG8_MMA(0, 1, At, B1); PG8_BAR; PG8_SCHED;
            PG8_LDA(At, 1, 1); PG8_STAGE_B(PG8_SB(1, 0), b3, 0, true); PG8_STAGE_B(PG8_SB(1, 1), b3, 1, true); PG8_STAGE_A(PG8_SA(1, 0), a3, 0, w0, w1);
            PG8_WAIT_V(8); PG8_WAIT_L(0); PG8_BAR; PG8_MMA(1, 0, At, B0); PG8_MMA(1, 1, At, B1); PG8_BAR; PG8_SCHED;
            } else {
            PG8_LDB(B0, 0, 0); PG8_SCHED; PG8_LDA(At, 0, 0); PG8_STAGE_A(PG8_SA(1, 1), a1, 1, vc0, vc1);
            PG8_WAIT_L(8); PG8_BAR; PG8_WAIT_L(0); PG8_MMA(0, 0, At, B0); PG8_BAR; PG8_SCHED;
            PG8_LDB(B1, 0, 1); PG8_STAGE_B(PG8_SB(0, 0), b2, 0, true);
            PG8_BAR; PG8_WAIT_L(0); PG8_MMA(0, 1, At, B1); PG8_BAR;
            PG8_LDA(At, 0, 1); PG8_STAGE_A(PG8_SA(0, 0), a2, 0, w0, w1);
            PG8_BAR; PG8_WAIT_L(0); PG8_MMA(1, 0, At, B0); PG8_BAR; PG8_SCHED;
            PG8_STAGE_B(PG8_SB(0, 1), b2, 1, true);
            PG8_WAIT_V(6); PG8_BAR; PG8_MMA(1, 1, At, B1); PG8_BAR;
            PG8_LDB(B0, 1, 0); PG8_SCHED; PG8_LDA(At, 1, 0); PG8_STAGE_A(PG8_SA(0, 1), a2, 1, w0, w1);
            PG8_WAIT_L(8); PG8_BAR; PG8_WAIT_L(0); PG8_MMA(0, 0, At, B0); PG8_BAR; PG8_SCHED;
            PG8_LDB(B1, 1, 1); PG8_STAGE_B(PG8_SB(1, 0), b3, 0, true);
            PG8_BAR; PG8_WAIT_L(0); PG8_MMA(0, 1, At, B1); PG8_BAR;
            PG8_LDA(At, 1, 1); PG8_STAGE_A(PG8_SA(1, 0), a3, 0, w0, w1);
            PG8_BAR; PG8_WAIT_L(0); PG8_MMA(1, 0, At, B0); PG8_BAR; PG8_SCHED;
            PG8_STAGE_B(PG8_SB(1, 1), b3, 1, true);
            PG8_WAIT_V(6); PG8_BAR; PG8_MMA(1, 1, At, B1); PG8_BAR;
            }
        }
        if constexpr (ALIGN_EPI) { if (wr == 0) PG8_BAR; }
        if constexpr (!Epi::AFTER_DRAIN) { E(acc, cur, wr, wc, fr, fq); S.done(cur); }
        if (!has_next) break;
#pragma unroll
        for (int a = 0; a < 2; ++a)
#pragma unroll
            for (int b = 0; b < 2; ++b)
#pragma unroll
                for (int m = 0; m < 4; ++m)
#pragma unroll
                    for (int n = 0; n < 2; ++n) acc[a][b][m][n] = (f32x4){0.f, 0.f, 0.f, 0.f};
        cur = nxt; cA = nA; cB = nB; ++ui;
        if constexpr (FP8) { pc = pn; hs = hsn; ntc = kK(cur.kind) / BK; kc1 = cur.kind == 1; }
        if constexpr (HET && !FP8) { vb[0] = vbn[0]; vb[1] = vbn[1]; hs = hsn; ntc = kK(cur.kind) / BK; }
        if constexpr (GATHER && !FP8) {
#pragma unroll
            for (int i = 0; i < 2; ++i) { vc0[i] = vn0[i]; vc1[i] = vn1[i]; } }
        if constexpr (ALIGN_EPI) { if (wr == 1) PG8_BAR; }
    }
    PG8_WAIT_V(0);
    if constexpr (!ALIGN_EPI) { if (wr == 0) PG8_BAR; }
    PG8_BAR;
    if constexpr (Epi::AFTER_DRAIN) { E.fused(acc, cur, wr, wc, fr, fq, lds, wid, lane); S.done(cur); }
#undef PG8_SA
#undef PG8_SB
#undef PG8_STAGE
#undef PG8_STAGE_A
#undef PG8_STAGE_B
#undef PG8_LDA
#undef PG8_LDB
#undef PG8_MMA
#undef PG8_WAIT_V
#undef PG8_WAIT_L
#undef PG8_BAR
#undef PG8_SCHED
}
}

namespace attn {
using bf16 = unsigned short;
constexpr int   D = 128, NW = 8, QBLK = 32, KVBLK = 64;
constexpr float SCALE = 0.088388347648318440f;
constexpr float THR = 8.f;
constexpr int SDEPTH = 2;
constexpr int LDQ = 1024, LDK = 256, LDO = 1024;
constexpr size_t SHM_V = KVBLK * D * 2, SHM_K = KVBLK * D * 2, SHM_ATTN = 2 * SHM_V + 2 * SHM_K + NW * 64 * 4;
using bf16x8 = __attribute__((ext_vector_type(8))) short;
using s16x4  = __attribute__((ext_vector_type(4))) short;
using f32x16 = __attribute__((ext_vector_type(16))) float;
using f32x8  = __attribute__((ext_vector_type(8))) float;
using u32x4  = __attribute__((ext_vector_type(4))) unsigned;
#define KSWZ(row, colB) ((row) * 256 + ((colB) ^ (((row) & 7) << 4)))
#define SBAR() __builtin_amdgcn_sched_barrier(0)
__device__ __forceinline__ int crow(int r, int hi) { return (r & 3) + 8 * (r >> 2) + 4 * hi; }
__device__ __forceinline__ unsigned cvtpk(float lo, float hi) {
  unsigned r; asm volatile("v_cvt_pk_bf16_f32 %0, %1, %2" : "=v"(r) : "v"(lo), "v"(hi)); return r;
}
template <typename TIn> struct Stage;
template <> struct Stage<bf16>  { using T = bf16x8;
  __device__ static __forceinline__ T ld8(const bf16* p) { return *reinterpret_cast<const bf16x8*>(p); }
  __device__ static __forceinline__ T ld8s(const char* sbase, unsigned off) { T r; asm volatile("global_load_dwordx4 %0, %1, %2" : "=v"(r) : "v"(off), "s"(sbase) : "memory"); return r; }
  __device__ static __forceinline__ bf16x8 tobf(T x) { return x; } };
__device__ __forceinline__ unsigned short f2bf_(float f) { unsigned u = __builtin_bit_cast(unsigned, f); return (unsigned short)((u + 0x7fffu + ((u >> 16) & 1u)) >> 16); }

__device__ __forceinline__ void partialSM(f32x16& p0, f32x16& p1, float& m_reg, float& mn, float& alpha) {
  constexpr float C = SCALE * 1.4426950408889634f;
  float pmax = p0[0]; for (int r = 1; r < 16; ++r) pmax = fmaxf(pmax, p0[r]); for (int r = 0; r < 16; ++r) pmax = fmaxf(pmax, p1[r]);
  { auto rr = __builtin_amdgcn_permlane32_swap(__float_as_uint(pmax), __float_as_uint(pmax), false, false);
    pmax = fmaxf(__uint_as_float(rr[0]), __uint_as_float(rr[1])); }
  if (__builtin_expect(__all(pmax - m_reg <= THR / SCALE), 1)) { mn = m_reg; alpha = 1.f; }
  else { mn = fmaxf(m_reg, pmax); alpha = __builtin_amdgcn_exp2f((m_reg - mn) * C); m_reg = mn; }
  float mnC = -mn * C;
  for (int r = 0; r < 16; ++r) p0[r] = fmaf(p0[r], C, mnC); for (int r = 0; r < 16; ++r) p1[r] = fmaf(p1[r], C, mnC);
  for (int r = 0; r < 16; ++r) p0[r] = __builtin_amdgcn_exp2f(p0[r]);
}
__device__ __forceinline__ void finishSM(f32x16& p0, f32x16& p1, float alpha, float& l_reg, bf16x8& pa0, bf16x8& pa1, bf16x8& pa2, bf16x8& pa3) {
  for (int r = 0; r < 16; ++r) p1[r] = __builtin_amdgcn_exp2f(p1[r]);
  float ps = 0; for (int r = 0; r < 16; ++r) ps += p0[r]; for (int r = 0; r < 16; ++r) ps += p1[r];
  { auto rr = __builtin_amdgcn_permlane32_swap(__float_as_uint(ps), __float_as_uint(ps), false, false);
    ps = __uint_as_float(rr[0]) + __uint_as_float(rr[1]); }
  l_reg = l_reg * alpha + ps;
#define PK4(P, BASE, OUT) do { unsigned a0 = cvtpk(P[BASE + 0], P[BASE + 1]), a1 = cvtpk(P[BASE + 2], P[BASE + 3]);   \
    unsigned b0 = cvtpk(P[BASE + 4], P[BASE + 5]), b1 = cvtpk(P[BASE + 6], P[BASE + 7]);                              \
    auto r0 = __builtin_amdgcn_permlane32_swap(a0, b0, false, false); auto r1 = __builtin_amdgcn_permlane32_swap(a1, b1, false, false); \
    u32x4 w = {r0[0], r1[0], r0[1], r1[1]}; OUT = *reinterpret_cast<bf16x8*>(&w); } while (0)
  PK4(p0, 0, pa0); PK4(p0, 8, pa1); PK4(p1, 0, pa2); PK4(p1, 8, pa3);
#undef PK4
}
__device__ __forceinline__ void qkt(f32x16& p0, f32x16& p1, const bf16* Ks, const bf16x8* qr, int r32, int hi) {
  p0 = f32x16{}; p1 = f32x16{};
  for (int d0 = 0; d0 < 8; ++d0) { int cb = (d0 * 16 + hi * 8) * 2;
    bf16x8 b0 = *reinterpret_cast<const bf16x8*>((const char*)Ks + KSWZ(r32, cb));
    bf16x8 b1 = *reinterpret_cast<const bf16x8*>((const char*)Ks + KSWZ(32 + r32, cb));
    p0 = __builtin_amdgcn_mfma_f32_32x32x16_bf16(b0, qr[d0], p0, 0, 0, 0);
    p1 = __builtin_amdgcn_mfma_f32_32x32x16_bf16(b1, qr[d0], p1, 0, 0, 0); }
}
__device__ __forceinline__ int v_st(int k, int c) { const int kk = (k & ~0xC) | ((k & 4) << 1) | ((k & 8) >> 1); return ((kk >> 3) * 4 + (c >> 5)) * 512 + ((kk & 7) * 32 + (c & 31)) * 2; }
__device__ __forceinline__ int v_rd_base(int lane) { return ((lane & 3) << 3) | (((lane >> 2) & 3) << 6) | (((lane >> 4) & 1) << 5) | (((lane >> 5) & 1) << 8); }
constexpr int v_rd_off(int d0, int ks, int half) { return d0 * 512 + ks * 4096 + half * 2048; }
template <int OFF> __device__ __forceinline__ s16x4 tr_read(int vb) {
  s16x4 r; asm volatile("ds_read_b64_tr_b16 %0, %1 offset:%2" : "=&v"(r) : "v"(vb), "i"(OFF) : "memory"); return r;
}
template <int D0> __device__ __forceinline__ void pv_one(f32x16& od, int vb, bf16x8 pa0, bf16x8 pa1, bf16x8 pa2, bf16x8 pa3) {
  const s16x4 l0 = tr_read<v_rd_off(D0, 0, 0)>(vb), h0 = tr_read<v_rd_off(D0, 0, 1)>(vb), l1 = tr_read<v_rd_off(D0, 1, 0)>(vb), h1 = tr_read<v_rd_off(D0, 1, 1)>(vb);
  const s16x4 l2 = tr_read<v_rd_off(D0, 2, 0)>(vb), h2 = tr_read<v_rd_off(D0, 2, 1)>(vb), l3 = tr_read<v_rd_off(D0, 3, 0)>(vb), h3 = tr_read<v_rd_off(D0, 3, 1)>(vb);
  asm volatile("s_waitcnt lgkmcnt(0)" ::: "memory"); SBAR();
#define PK(L, H) (bf16x8){L[0], L[1], L[2], L[3], H[0], H[1], H[2], H[3]}
  od = __builtin_amdgcn_mfma_f32_32x32x16_bf16(pa0, PK(l0, h0), od, 0, 0, 0);
  od = __builtin_amdgcn_mfma_f32_32x32x16_bf16(pa1, PK(l1, h1), od, 0, 0, 0);
  od = __builtin_amdgcn_mfma_f32_32x32x16_bf16(pa2, PK(l2, h2), od, 0, 0, 0);
  od = __builtin_amdgcn_mfma_f32_32x32x16_bf16(pa3, PK(l3, h3), od, 0, 0, 0);
#undef PK
}
__device__ __forceinline__ void pv_d0(f32x16* o, int vb, bf16x8 pa0, bf16x8 pa1, bf16x8 pa2, bf16x8 pa3) {
  pv_one<0>(o[0], vb, pa0, pa1, pa2, pa3); pv_one<1>(o[1], vb, pa0, pa1, pa2, pa3); pv_one<2>(o[2], vb, pa0, pa1, pa2, pa3); pv_one<3>(o[3], vb, pa0, pa1, pa2, pa3);
}

template <bool FAST, class Hook>
__device__ __forceinline__ void attn_dense_body(const bf16* __restrict__ Qb, const bf16* __restrict__ Kh, const bf16* __restrict__ Vh,
                                                bf16* __restrict__ Ob, int seq, char* lds, Hook& hk, int wave_) {
  using St = Stage<bf16>; using SQ = Stage<bf16>; typedef bf16 TQ;
  int lane; asm volatile("v_mbcnt_lo_u32_b32 %0, -1, 0\n\tv_mbcnt_hi_u32_b32 %0, -1, %0" : "=v"(lane));
  const int wid = wave_, tid = wid * 64 + lane, r32 = lane & 31, hi = lane >> 5;
  bf16* V_lds = (bf16*)lds; bf16* K_lds = (bf16*)(lds + 2 * SHM_V);
  float* ws = (float*)(lds + 2 * SHM_V + 2 * SHM_K) + wid * 64; float* li_l = ws; float* al_l = ws + 32;
  float m_reg = -1e30f, l_reg = 0; f32x16 o[4] = {}; bf16x8 qr[8];
  const TQ* Qw = Qb + (long)(wid * QBLK + r32) * LDQ + hi * 8;
#pragma unroll
  for (int d0 = 0; d0 < 8; ++d0) { qr[d0] = SQ::tobf(SQ::ld8(Qw + d0 * 16));
    if constexpr (FAST) { constexpr float C = SCALE * 1.4426950408889634f; u32x4 w = *reinterpret_cast<u32x4*>(&qr[d0]);
      w.x = cvtpk(__uint_as_float(w.x << 16) * C, __uint_as_float(w.x & 0xffff0000u) * C); w.y = cvtpk(__uint_as_float(w.y << 16) * C, __uint_as_float(w.y & 0xffff0000u) * C);
      w.z = cvtpk(__uint_as_float(w.z << 16) * C, __uint_as_float(w.z & 0xffff0000u) * C); w.w = cvtpk(__uint_as_float(w.w << 16) * C, __uint_as_float(w.w & 0xffff0000u) * C);
      qr[d0] = *reinterpret_cast<bf16x8*>(&w); } }
  const int sr = tid >> 4, sc = (tid & 15) * 8, vst0 = v_st(sr, sc), vst1 = v_st(32 + sr, sc);
  const int vb0 = (int)(uintptr_t)V_lds + v_rd_base(lane);
  struct { typename St::T vs0, vs1, ks0, ks1; } sr_[SDEPTH];
  const unsigned slo = (unsigned)(sr * LDK + sc) * 2u;
#define SLOAD(i, k0) do { const char* vb_ = (const char*)(Vh + (long)(k0) * LDK); const char* kb_ = (const char*)(Kh + (long)(k0) * LDK); \
    sr_[i].vs0 = St::ld8s(vb_, slo); sr_[i].vs1 = St::ld8s(vb_ + 32 * LDK * 2, slo); \
    sr_[i].ks0 = St::ld8s(kb_, slo); sr_[i].ks1 = St::ld8s(kb_ + 32 * LDK * 2, slo); } while (0)
#define SWRITE(b, i) do { *(bf16x8*)((char*)V_lds + (b) * SHM_V + vst0) = St::tobf(sr_[i].vs0);          \
    *(bf16x8*)((char*)V_lds + (b) * SHM_V + vst1) = St::tobf(sr_[i].vs1); int kc = sc * 2;               \
    *(bf16x8*)((char*)K_lds + (b) * SHM_K + KSWZ(sr, kc)) = St::tobf(sr_[i].ks0);                       \
    *(bf16x8*)((char*)K_lds + (b) * SHM_K + KSWZ(32 + sr, kc)) = St::tobf(sr_[i].ks1); } while (0)
#define SWAIT() do { if constexpr (SDEPTH == 2) asm volatile("s_waitcnt vmcnt(4)" ::: "memory"); else asm volatile("s_waitcnt vmcnt(0)" ::: "memory"); } while (0)
#define RESC(a) do { if (__any((a) < 1.f)) { if (hi == 0) al_l[r32] = (a); asm volatile("s_waitcnt lgkmcnt(0)" ::: "memory"); \
    for (int d = 0; d < 4; ++d) for (int r = 0; r < 16; ++r) o[d][r] *= al_l[crow(r, hi)]; } } while (0)
  f32x16 pA0, pA1, pB0, pB1; float mnA = 0.f, mnB = 0.f, alA = 1.f, alB = 1.f; bf16x8 pa0, pa1, pa2, pa3; const int NT = seq / KVBLK;
#define PSM(P0, P1, MN, AL) do { if constexpr (FAST) { _Pragma("unroll") for (int r_ = 0; r_ < 16; ++r_) P0[r_] = __builtin_amdgcn_exp2f(P0[r_]); } else partialSM(P0, P1, m_reg, MN, AL); } while (0)
#define RESCF(a) do { if constexpr (!FAST) RESC(a); } while (0)
  constexpr int SE = 0, SO = SDEPTH - 1;
  SLOAD(SE, 0); asm volatile("s_waitcnt vmcnt(0)" ::: "memory"); SWRITE(0, SE); __syncthreads();
  qkt(pA0, pA1, K_lds, qr, r32, hi); PSM(pA0, pA1, mnA, alA);
  SLOAD(SO, KVBLK); if constexpr (SDEPTH == 2) { if (2 < NT) SLOAD(SE, 2 * KVBLK); }
  SWAIT(); SWRITE(1, SO); __syncthreads();
  for (int j = 1; j + 1 < NT; j += 2) {
    SBAR(); qkt(pB0, pB1, (bf16*)((char*)K_lds + SHM_K), qr, r32, hi);
    finishSM(pA0, pA1, alA, l_reg, pa0, pa1, pa2, pa3); SBAR();
    SLOAD(SO, (j + SDEPTH) * KVBLK); SBAR();
    pv_d0(o, vb0, pa0, pa1, pa2, pa3); PSM(pB0, pB1, mnB, alB);
    __syncthreads(); SWAIT(); SWRITE(0, SE);
    RESCF(alB); hk.step(true); __syncthreads();
    SBAR(); qkt(pA0, pA1, K_lds, qr, r32, hi);
    finishSM(pB0, pB1, alB, l_reg, pa0, pa1, pa2, pa3); SBAR();
    if (SDEPTH == 1 || j + 3 < NT) SLOAD(SE, (j + 1 + SDEPTH) * KVBLK); SBAR();
    pv_d0(o, vb0 + (int)SHM_V, pa0, pa1, pa2, pa3); PSM(pA0, pA1, mnA, alA);
    __syncthreads(); if (SDEPTH == 1 || j + 3 < NT) SWAIT(); else asm volatile("s_waitcnt vmcnt(0)" ::: "memory"); SWRITE(1, SO);
    RESCF(alA); hk.step(SDEPTH == 1 || j + 3 < NT); __syncthreads();
  }
  SBAR(); qkt(pB0, pB1, (bf16*)((char*)K_lds + SHM_K), qr, r32, hi);
  finishSM(pA0, pA1, alA, l_reg, pa0, pa1, pa2, pa3); SBAR();
  pv_d0(o, vb0, pa0, pa1, pa2, pa3); PSM(pB0, pB1, mnB, alB);
  __syncthreads(); RESCF(alB);
  finishSM(pB0, pB1, alB, l_reg, pa0, pa1, pa2, pa3); SBAR();
  pv_d0(o, vb0 + (int)SHM_V, pa0, pa1, pa2, pa3);
  if (hi == 0) li_l[r32] = l_reg; asm volatile("s_waitcnt lgkmcnt(0)" ::: "memory");
  float rli[16];
#pragma unroll
  for (int r = 0; r < 16; ++r) rli[r] = __builtin_amdgcn_rcpf(li_l[crow(r, hi)]);
  bf16* Ow = Ob + (long)(wid * QBLK) * LDO;
#pragma unroll
  for (int r = 0; r < 16; ++r) { int orow = crow(r, hi);
    for (int d0 = 0; d0 < 4; ++d0) Ow[(long)orow * LDO + d0 * 32 + r32] = f2bf_(o[d0][r] * rli[r]); }
#undef SLOAD
#undef SWRITE
#undef SWAIT
#undef RESC
#undef RESCF
#undef PSM
}

#undef KSWZ
#undef SBAR
}

#define GAS __attribute__((address_space(1)))
#define LAS __attribute__((address_space(3)))
typedef unsigned short bf16;
typedef unsigned v4u __attribute__((ext_vector_type(4)));
typedef float f32x4 __attribute__((ext_vector_type(4)));
typedef short bf16x8 __attribute__((ext_vector_type(8)));
typedef GAS unsigned gu32;
typedef GAS unsigned long long gu64;
#define RLX_AGENT __ATOMIC_RELAXED, __HIP_MEMORY_SCOPE_AGENT
#define LDS_WAIT() asm volatile("s_waitcnt lgkmcnt(0)" ::: "memory")
#define VM_WAIT() asm volatile("s_waitcnt vmcnt(0)" ::: "memory")
__device__ __forceinline__ unsigned f2bf(float f) { unsigned u = __builtin_bit_cast(unsigned, f); return (u + 0x7fffu + ((u >> 16) & 1u)) >> 16; }
__device__ __forceinline__ unsigned pk2(float lo, float hi) { return f2bf(lo) | (f2bf(hi) << 16); }
__device__ __forceinline__ float bflo(unsigned w) { return __uint_as_float(w << 16); }
__device__ __forceinline__ float bfhi(unsigned w) { return __uint_as_float(w & 0xffff0000u); }

#define XB_TMO      128
#define XB_XCNT(j)  (256  + 64 * (j))
#define XB_XSUB(j)  (1280 + 64 * (j))
#define XB_XGEN(j)  (2304 + 64 * (j))
#define XB_TOP      3328
#define XB_TOPGEN   3392
#define XCD_BAR_WORDS 3456
#define XB_SPIN_CAP (1u << 18)

__device__ __forceinline__ unsigned xb_ld(unsigned* p)              { return __hip_atomic_load(p, __ATOMIC_RELAXED, __HIP_MEMORY_SCOPE_AGENT); }
__device__ __forceinline__ unsigned xb_add(unsigned* p, unsigned v) { return __hip_atomic_fetch_add(p, v, __ATOMIC_RELAXED, __HIP_MEMORY_SCOPE_AGENT); }
__device__ __forceinline__ unsigned xb_xcc_id() { return (unsigned)__builtin_amdgcn_s_getreg((3 << 11) | 20) & 0xFu; }
#define XB_SPIN(cond, bar) do { unsigned _sp = 0; while (cond) { __builtin_amdgcn_s_sleep(1); \
    if ((++_sp & 255u) == 0u) { if (xb_ld(&(bar)[XB_TMO])) break; if (_sp > XB_SPIN_CAP) { atomicAdd(&(bar)[XB_TMO], 1u); break; } } } } while (0)

__device__ __forceinline__ bool xb_thread0(int wave) { int l; asm volatile("v_mbcnt_lo_u32_b32 %0, -1, 0\n\tv_mbcnt_hi_u32_b32 %0, -1, %0" : "=v"(l)); return wave == 0 && l == 0; }
struct XcdBarrier {
    int wave;
    unsigned* bar; unsigned x;
    volatile LAS unsigned* st;
};

__device__ __forceinline__ XcdBarrier xcd_barrier_post(unsigned* bar, volatile LAS unsigned* st, int wave) {
    XcdBarrier b; b.wave = wave; b.bar = bar; b.x = xb_xcc_id(); b.st = st;
    if (xb_thread0(wave)) (void)xb_add(&bar[XB_XCNT(b.x)], 1u);
    return b;
}
__device__ __forceinline__ void xcd_barrier_complete(unsigned* bar, unsigned x, unsigned& nloc, unsigned& nx) {
    const unsigned G = gridDim.x * gridDim.y * gridDim.z;
    unsigned sum, cnt, mine, sp = 0u;
    for (;;) {
        sum = 0u; cnt = 0u; mine = 0u;
#pragma unroll
        for (unsigned j = 0; j < 16; ++j) { const unsigned c = xb_ld(&bar[XB_XCNT(j)]); sum += c; cnt += (c > 0u) ? 1u : 0u; mine = (j == x) ? c : mine; }
        if (sum == G) break;
        __builtin_amdgcn_s_sleep(1);
        if ((++sp & 255u) == 0u) { if (xb_ld(&bar[XB_TMO])) break; if (sp > XB_SPIN_CAP) { atomicAdd(&bar[XB_TMO], 1u); break; } }
    }
    nloc = mine > 0u ? mine : 1u; nx = cnt > 0u ? cnt : 1u;
}

__device__ __forceinline__ void xcd_barrier(const XcdBarrier& b) {
    asm volatile("s_waitcnt vmcnt(0)" ::: "memory");
    __syncthreads();
    if (xb_thread0(b.wave)) {
        unsigned* bar = b.bar;
        __builtin_amdgcn_s_waitcnt(0);
        unsigned nloc = b.st[0], nx = b.st[1];
        if (nloc == 0u) { xcd_barrier_complete(bar, b.x, nloc, nx); b.st[0] = nloc; b.st[1] = nx; }
        const unsigned old = xb_add(&bar[XB_XSUB(b.x)], 1u);
        const unsigned gen = old / nloc;
        if (old + 1u == (gen + 1u) * nloc) {
            __builtin_amdgcn_fence(__ATOMIC_RELEASE, "agent");
            asm volatile("s_waitcnt vmcnt(0)" ::: "memory");
            const unsigned og = xb_add(&bar[XB_TOP], 1u);
            const unsigned tg = og / nx;
            if (og + 1u == (tg + 1u) * nx) xb_add(&bar[XB_TOPGEN], 1u);
            else XB_SPIN(xb_ld(&bar[XB_TOPGEN]) == tg, bar);
            __builtin_amdgcn_fence(__ATOMIC_ACQUIRE, "agent");
            xb_add(&bar[XB_XGEN(b.x)], 1u);
            asm volatile("s_waitcnt vmcnt(0)" ::: "memory");
        } else {
            XB_SPIN(xb_ld(&bar[XB_XGEN(b.x)]) == gen, bar);
            __builtin_amdgcn_fence(__ATOMIC_ACQUIRE, "agent");
            asm volatile("s_waitcnt vmcnt(0)" ::: "memory");
        }
    }
    __syncthreads();
}


struct Frame {
    LAS unsigned char* lds;
    volatile LAS unsigned* MISC;
    gu32* ctl;
    unsigned char* ws;
    int wave;
    int vcu, G;
    float* out;
};
__device__ __forceinline__ int lane_id() { int l; asm volatile("v_mbcnt_lo_u32_b32 %0, -1, 0\n\tv_mbcnt_hi_u32_b32 %0, -1, %0" : "=v"(l)); return l; }
struct TokRec { int e0, e1, pos0, pos1; float w0, w1; int s0, s1; };

__device__ __forceinline__ float wave_sum(float v) {
#pragma unroll
    for (int o = 1; o < 64; o <<= 1) v += __shfl_xor(v, o);
    return v;
}
__device__ __forceinline__ void transpose_item(const float* W, int ldw, int k0, int n0, bf16* dst, int ldd, LAS float* scr, int lane) {
    const int r8 = lane >> 3, c4 = (lane & 7) * 4;
    f32x4 v[8];
#pragma unroll
    for (int i = 0; i < 8; ++i) v[i] = *(const GAS f32x4*)(W + (size_t)(k0 + 8 * i + r8) * ldw + n0 + c4);
#pragma unroll
    for (int i = 0; i < 8; ++i) { LAS float* q = scr + (8 * i + r8) * 33 + c4; q[0] = v[i].x; q[1] = v[i].y; q[2] = v[i].z; q[3] = v[i].w; }
    LDS_WAIT(); asm volatile("" ::: "memory");
    const int c = lane & 7;
#pragma unroll
    for (int j = 0; j < 4; ++j) { const int n = (lane >> 3) + 8 * j; const LAS float* s = scr + (8 * c) * 33 + n;
        v4u o; o.x = pk2(s[0 * 33], s[1 * 33]); o.y = pk2(s[2 * 33], s[3 * 33]); o.z = pk2(s[4 * 33], s[5 * 33]); o.w = pk2(s[6 * 33], s[7 * 33]);
        *(GAS v4u*)(dst + (size_t)n * ldd + 8 * c) = o; }
    LDS_WAIT(); asm volatile("" ::: "memory");
}

__device__ __forceinline__ void p0_prologue(Frame& F, const float* x, const float* g1, const float* w_in, const float* w_co, const float* w_ao, const float* w_o, const float* w_grp, const float* w_rt, int part, int gw_, int ngw_) {
    LAS float* scr = (LAS float*)(F.lds + F.wave * 16384);
    const int gw = part == 2 ? gw_ : F.vcu * 8 + F.wave, NGW = part == 2 ? ngw_ : F.G * 8, lane = lane_id(), tid = F.wave * 64 + lane;
    constexpr int I_IN = 16 * (DIN / 32);
    constexpr int I_SQ = 16 * 32;
    constexpr int NITEMS = I_IN + 3 * I_SQ;
    bf16* WinT = (bf16*)(F.ws + WS_WIN);
    for (int it = (part == 2 ? I_IN : 0) + gw; it < (part == 1 ? I_IN : NITEMS); it += NGW) {
        int r = it;
        if (r < I_IN) { const int nblk = DIN / 32, kb = r / nblk, nb = r % nblk, n0 = 32 * nb;
            int drow = n0; if (n0 >= 1024 && n0 < 3072) { const int sx = n0 >= 2048 ? 1 : 0, c0 = n0 - 1024 - 1024 * sx; drow = 1024 + 256 * (c0 >> 7) + 128 * sx + (c0 & 127); }
            transpose_item(w_in, DIN, 64 * kb, n0, WinT + (size_t)drow * 1024 + 64 * kb, 1024, scr, lane); continue; } r -= I_IN;
        if (r < 3 * I_SQ) { const int which = r / I_SQ, q = r % I_SQ, kb = q / 32, nb = q % 32;
            const float* W = which == 0 ? w_co : which == 1 ? w_ao : w_o; bf16* D = (bf16*)(F.ws + (which == 0 ? WS_WC : which == 1 ? WS_WA : WS_WO));
            transpose_item(W, 1024, 64 * kb, 32 * nb, D + (size_t)(32 * nb) * 1024 + 64 * kb, 1024, scr, lane); continue; } r -= 3 * I_SQ;
    }
    if (part == 2) return;
    { bf16* hi = (bf16*)(F.ws + WS_WRT); bf16* lo = hi + NROUTE_PAD * 1024;
      for (int i = F.vcu * 512 + tid; i < NROUTE_PAD * 1024; i += F.G * 512) { const int n = i >> 10, k = i & 1023;
          const float v = n < 8 ? w_grp[k * 8 + n] : n < NROUTE ? w_rt[k * 64 + (n - 8)] : 0.f;
          const unsigned h = f2bf(v); const float r = v - __uint_as_float(h << 16); hi[i] = (bf16)h; lo[i] = (bf16)f2bf(r); } }
    { float* ct = (float*)(F.ws + WS_ROPE); float* st = ct + 2048;
      for (int i = F.vcu * 512 + tid; i < 2048; i += F.G * 512) { const int pos = i >> 5, j = i & 31;
          const float inv = exp2f(-(float)(2 * j) * (13.287712379549449f / 64.0f));
          const float ang = (float)pos * inv; ct[i] = cosf(ang); st[i] = sinf(ang); } }
    { bf16* U = (bf16*)(F.ws + WS_R1);
      for (int m = gw; m < T; m += NGW) {
          const GAS f32x4* xr = (const GAS f32x4*)(x + (size_t)m * DM) + lane; const GAS f32x4* gr = (const GAS f32x4*)g1 + lane;
          f32x4 v[4]; float s = 0.f;
#pragma unroll
          for (int j = 0; j < 4; ++j) { v[j] = xr[64 * j]; s += (v[j].x * v[j].x + v[j].y * v[j].y) + (v[j].z * v[j].z + v[j].w * v[j].w); }
          const float rstd = 1.f / sqrtf(wave_sum(s) * (1.f / DM) + EPS);
          GAS unsigned long long* o8 = (GAS unsigned long long*)(U + (size_t)m * DM) + lane;
#pragma unroll
          for (int j = 0; j < 4; ++j) { const f32x4 g = gr[64 * j];
              o8[64 * j] = (unsigned long long)pk2(v[j].x * rstd * g.x, v[j].y * rstd * g.y) | ((unsigned long long)pk2(v[j].z * rstd * g.z, v[j].w * rstd * g.w) << 32); } } }
}

constexpr int I_E13 = 16 * 16, I_E2 = 8 * 32, I_EPER = 2 * I_E13 + I_E2, NITEMS_E = NE * I_EPER;
__device__ __forceinline__ void glds16(const void* gsrc, unsigned lds_dst) { unsigned keep;
    asm volatile("s_mov_b32 %0, m0\n\ts_mov_b32 m0, %2\n\ts_nop 0\n\tglobal_load_lds_dwordx4 %1, off\n\ts_mov_b32 m0, %0" : "=&s"(keep) : "v"(gsrc), "s"(lds_dst) : "memory"); }
__device__ __forceinline__ void glds16s(const void* sbase, unsigned voff, unsigned lds_dst) { unsigned keep;
    (void)keep; asm volatile("s_mov_b32 m0, %2\n\ts_nop 0\n\tglobal_load_lds_dwordx4 %0, %1" :: "v"(voff), "s"(sbase), "s"(lds_dst) : "memory"); }
struct ExpertItem { const float* src; int ldw; unsigned char* dst; int ldd; };
__device__ __forceinline__ ExpertItem expert_item(int it, const float* w1, const float* w3, const float* w2, unsigned char* ws) {
    ExpertItem d; const int m = it >> 14, e = (it >> 8) & 63, q = it & 255;
    if (m < 2) { const int kb = q >> 4, n0 = (q & 15) * 32;
        d.src = (m == 0 ? w1 : w3) + (size_t)e * 1024 * 512 + (size_t)(64 * kb) * 512 + n0; d.ldw = 512;
        const int drow = 256 * (n0 >> 7) + 128 * m + (n0 & 127);
        d.dst = ws + WS_W13 + ((size_t)e * 1024 + drow) * 1024 + 64 * kb; d.ldd = 1024; }
    else { const int kb = q >> 5, nb = q & 31;
        d.src = w2 + (size_t)e * 512 * 1024 + (size_t)(64 * kb) * 1024 + 32 * nb; d.ldw = 1024;
        d.dst = ws + WS_W2 + ((size_t)e * 1024 + 32 * nb) * 512 + 64 * kb; d.ldd = 512; }
    return d;
}
__device__ __forceinline__ unsigned cvtpk_(float lo, float hi) { unsigned r; asm("v_cvt_pk_bf16_f32 %0, %1, %2" : "=v"(r) : "v"(lo), "v"(hi)); return r; }
struct PrepHook {
    const float *w1, *w3, *w2; unsigned char* ws; LAS unsigned char* lds; int first, stride, s; unsigned buf;
    __device__ __forceinline__ void step(bool retired) {
        const int it = first + (s >> 2) * stride, ph = s & 3; ++s;
        if (it >= NITEMS_E) return;
        if (!retired && ph >= 2) asm volatile("s_waitcnt vmcnt(0)" ::: "memory");
        const ExpertItem d = expert_item(it, w1, w3, w2, ws); const int lane = lane_id();
        if (ph < 2) {
#pragma unroll
            for (int pp = 0; pp < 4; ++pp) { const int p = 4 * ph + pp;
                glds16s((const char*)d.src + (size_t)(32 * p) * d.ldw, (unsigned)((lane >> 3) * d.ldw * 4 + 16 * ((lane & 7) ^ p)), buf + p * 1024); asm volatile("" ::: "memory"); }
        } else {
#pragma unroll
            for (int jj = 0; jj < 2; ++jj) readback(d, 2 * (ph - 2) + jj, lane);
        }
    }
    __device__ __forceinline__ void readback(const ExpertItem& d, int j, int lane) { const int n = (lane >> 3) + 8 * j, c = lane & 7;
        const LAS float* sp = (const LAS float*)(lds + buf + (8 * c) * 128 + (((n >> 2) ^ c) << 4) + (n & 3) * 4);
        const float v[8] = {sp[0], sp[32], sp[64], sp[96], sp[128], sp[160], sp[192], sp[224]};
        typedef unsigned v2u_ __attribute__((ext_vector_type(2))); unsigned o0, o1; cvt8_fp8_x32(v, o0, o1); const v2u_ o = {o0, o1};
        asm volatile("global_store_dwordx2 %0, %1, %2" :: "v"((unsigned)((lane >> 3) * d.ldd + 8 * c)), "v"(o), "s"(d.dst + (size_t)(8 * j) * d.ldd) : "memory"); }
    __device__ __forceinline__ void whole(const ExpertItem& d, int lane) {
#pragma unroll
        for (int p = 0; p < 8; ++p) { glds16s((const char*)d.src + (size_t)(32 * p) * d.ldw, (unsigned)((lane >> 3) * d.ldw * 4 + 16 * ((lane & 7) ^ p)), buf + p * 1024); asm volatile("" ::: "memory"); }
        asm volatile("s_waitcnt vmcnt(0)" ::: "memory");
#pragma unroll
        for (int j = 0; j < 4; ++j) readback(d, j, lane);
        asm volatile("s_waitcnt lgkmcnt(0)" ::: "memory");
    }
};
struct NoHook { __device__ __forceinline__ void step(bool) {} };

__device__ __forceinline__ void unpack8(const v4u w, float (&f)[8]) { f[0] = bflo(w.x); f[1] = bfhi(w.x); f[2] = bflo(w.y); f[3] = bfhi(w.y); f[4] = bflo(w.z); f[5] = bfhi(w.z); f[6] = bflo(w.w); f[7] = bfhi(w.w); }
__device__ __forceinline__ void p2_elementwise(Frame& F, const float* conv_w) {
    const int gw = F.vcu * 8 + F.wave, NGW = F.G * 8, lane = lane_id();
    const bf16* CB = (const bf16*)(F.ws + WS_CB); const bf16* PP = (const bf16*)(F.ws + WS_CC); bf16* AC = (bf16*)(F.ws + WS_R1);
    for (int it = gw; it < (T / 4) * 2; it += NGW) {
        const int rb = it >> 1, c0 = (it & 1) * 512 + lane * 8, r0 = rb * 4, s0 = r0 & (SEQ - 1);
        v4u p_[6], cb_[4];
#pragma unroll
        for (int i = 0; i < 6; ++i) { int r = r0 - 1 + i; r = r < 0 ? 0 : (r > T - 1 ? T - 1 : r); p_[i] = *(const GAS v4u*)(PP + (size_t)r * 1024 + c0); }
#pragma unroll
        for (int i = 0; i < 4; ++i) cb_[i] = *(const GAS v4u*)(CB + (size_t)(r0 + i) * 1024 + c0);
        float w0[8], w1[8], w2[8];
#pragma unroll
        for (int h = 0; h < 2; ++h) { const f32x4 a = *(const GAS f32x4*)(conv_w + c0 + 4 * h), b = *(const GAS f32x4*)(conv_w + 1024 + c0 + 4 * h), c = *(const GAS f32x4*)(conv_w + 2048 + c0 + 4 * h);
#pragma unroll
            for (int i = 0; i < 4; ++i) { w0[4 * h + i] = a[i]; w1[4 * h + i] = b[i]; w2[4 * h + i] = c[i]; } }
        float prev[8], cur[8], nxt[8];
        const float zf = (s0 > 0) ? 1.f : 0.f, zl = (s0 + 4 < SEQ) ? 1.f : 0.f;
        unpack8(p_[0], prev);
#pragma unroll
        for (int i = 0; i < 8; ++i) prev[i] *= zf;
        unpack8(p_[1], cur);
#pragma unroll
        for (int rr = 0; rr < 4; ++rr) {
            unpack8(p_[rr + 2], nxt);
            if (rr == 3) {
#pragma unroll
                for (int i = 0; i < 8; ++i) nxt[i] *= zl; }
            float cb8[8]; unpack8(cb_[rr], cb8); float o[8];
#pragma unroll
            for (int i = 0; i < 8; ++i) { o[i] = cb8[i] * (w0[i] * prev[i] + w1[i] * cur[i] + w2[i] * nxt[i]); prev[i] = cur[i]; cur[i] = nxt[i]; }
            v4u ov; ov.x = pk2(o[0], o[1]); ov.y = pk2(o[2], o[3]); ov.z = pk2(o[4], o[5]); ov.w = pk2(o[6], o[7]);
            *(GAS v4u*)(AC + (size_t)(r0 + rr) * 1024 + c0) = ov; }
    }
}

__device__ __forceinline__ void p6_route(Frame& F, const float* g2, int blk0, int blkstep) {
    const int lane = lane_id(), wave = F.wave, tid = wave * 64 + lane, r16 = lane & 15, q4 = lane >> 4, tt = wave & 3, kh = wave >> 2;
    constexpr int WROW = 272;
    LAS unsigned char* Wl = F.lds;
    LAS float* part = (LAS float*)(F.lds + 90112);
    LAS float* lgall = (LAS float*)(F.lds + 90112 + 21504);
    bf16* U2 = (bf16*)(F.ws + WS_R1); const bf16* Whi = (const bf16*)(F.ws + WS_WRT);
    TokRec* recs = (TokRec*)(F.ws + WS_TOK); v4u* lst = (v4u*)(F.ws + WS_LIST); unsigned* cnt = (unsigned*)(F.ctl + CW_CNT);
    LAS float* gl = (LAS float*)(F.lds + (kh ? 132096 : 87040));
    if (tid < 256) { const f32x4 gv = *(const GAS f32x4*)(g2 + tid * 4); *(LAS f32x4*)(F.lds + (tid < 128 ? 87040 + tid * 16 : 132096 + (tid - 128) * 16)) = gv; }
    unsigned goff[10];
#pragma unroll
    for (int i = 0; i < 10; ++i) { const int q = tid + 512 * i, rowid = q >> 4, c16 = q & 15, h = rowid / 160, hl = (rowid / 80) & 1, n = rowid % 80; goff[i] = (unsigned)(hl * (NROUTE_PAD * 1024) + n * 1024 + 512 * h + 8 * c16); }
    for (int blk = blk0; blk < T / 64; blk += blkstep) {
        const int t0 = blk * 64 + tt * 16;
        const float* xr = F.out + (size_t)(t0 + r16) * DM + kh * 512 + q4 * 8;
        const LAS float* gr = gl + q4 * 8;
        unsigned char* ur = (unsigned char*)U2 + (size_t)(t0 + r16) * DM + kh * 512 + q4 * 8;
        v4u wreg[10];
#pragma unroll
        for (int i = 0; i < 10; ++i) wreg[i] = *(const GAS v4u*)(Whi + goff[i]);
        f32x4 acc[5];
#pragma unroll
        for (int nb = 0; nb < 5; ++nb) acc[nb] = (f32x4){0.f, 0.f, 0.f, 0.f};
        float ss = 0.f;
#pragma unroll 1
        for (int r = 0; r < 4; ++r) {
            f32x4 xa[4], xb[4];
#pragma unroll
            for (int s4 = 0; s4 < 4; ++s4) { xa[s4] = *(const GAS f32x4*)(xr + r * 128 + s4 * 32); xb[s4] = *(const GAS f32x4*)(xr + r * 128 + s4 * 32 + 4); }
            __syncthreads();
#pragma unroll
            for (int i = 0; i < 10; ++i) { const int q = tid + 512 * i; *(LAS v4u*)(Wl + (q >> 4) * WROW + (q & 15) * 16) = wreg[i]; }
            __syncthreads();
            if (r < 3) {
#pragma unroll
                for (int i = 0; i < 10; ++i) wreg[i] = *(const GAS v4u*)(Whi + goff[i] + (r + 1) * 128); }
#pragma unroll
            for (int s4 = 0; s4 < 4; ++s4) {
                const f32x4 ga = *(const LAS f32x4*)(gr + r * 128 + s4 * 32), gb = *(const LAS f32x4*)(gr + r * 128 + s4 * 32 + 4);
                float v[8];
#pragma unroll
                for (int i = 0; i < 4; ++i) { ss += xa[s4][i] * xa[s4][i] + xb[s4][i] * xb[s4][i]; v[i] = xa[s4][i] * ga[i]; v[4 + i] = xb[s4][i] * gb[i]; }
                v4u hv; hv.x = cvtpk_(v[0], v[1]); hv.y = cvtpk_(v[2], v[3]); hv.z = cvtpk_(v[4], v[5]); hv.w = cvtpk_(v[6], v[7]);
                v4u lv; lv.x = cvtpk_(v[0] - bflo(hv.x), v[1] - bfhi(hv.x)); lv.y = cvtpk_(v[2] - bflo(hv.y), v[3] - bfhi(hv.y));
                lv.z = cvtpk_(v[4] - bflo(hv.z), v[5] - bfhi(hv.z)); lv.w = cvtpk_(v[6] - bflo(hv.w), v[7] - bfhi(hv.w));
                { typedef unsigned v2u_ __attribute__((ext_vector_type(2))); unsigned o0, o1; cvt8_fp8(v, o0, o1); const v2u_ o8 = {o0, o1}; *(GAS v2u_*)(ur + r * 128 + s4 * 32) = o8; }
                const bf16x8 Ah = __builtin_bit_cast(bf16x8, hv), Al = __builtin_bit_cast(bf16x8, lv);
#pragma unroll
                for (int nb = 0; nb < 5; ++nb) {
                    const bf16x8 Bh = *(const LAS bf16x8*)(Wl + ((kh * 2 + 0) * NROUTE_PAD + nb * 16 + r16) * WROW + (s4 * 32 + q4 * 8) * 2);
                    const bf16x8 Bl = *(const LAS bf16x8*)(Wl + ((kh * 2 + 1) * NROUTE_PAD + nb * 16 + r16) * WROW + (s4 * 32 + q4 * 8) * 2);
                    acc[nb] = __builtin_amdgcn_mfma_f32_16x16x32_bf16(Ah, Bh, acc[nb], 0, 0, 0);
                    acc[nb] = __builtin_amdgcn_mfma_f32_16x16x32_bf16(Al, Bh, acc[nb], 0, 0, 0);
                    acc[nb] = __builtin_amdgcn_mfma_f32_16x16x32_bf16(Ah, Bl, acc[nb], 0, 0, 0); } }
        }
        if (kh == 1) {
#pragma unroll
            for (int nb = 0; nb < 5; ++nb)
#pragma unroll
                for (int rr = 0; rr < 4; ++rr) part[(tt * 21 + nb * 4 + rr) * 64 + lane] = acc[nb][rr];
            part[(tt * 21 + 20) * 64 + lane] = ss; }
        __syncthreads();
        if (kh == 0) {
#pragma unroll
            for (int nb = 0; nb < 5; ++nb)
#pragma unroll
                for (int rr = 0; rr < 4; ++rr) acc[nb][rr] += part[(tt * 21 + nb * 4 + rr) * 64 + lane];
            ss += part[(tt * 21 + 20) * 64 + lane];
            ss += __shfl_xor(ss, 16); ss += __shfl_xor(ss, 32);
            const float rstd = 1.f / sqrtf(ss * (1.f / DM) + EPS);
            LAS float* lg = lgall + tt * 16 * NROUTE_PAD;
#pragma unroll
            for (int rr = 0; rr < 4; ++rr) { const float rs = __shfl(rstd, 4 * q4 + rr);
#pragma unroll
                for (int nb = 0; nb < 5; ++nb) lg[(4 * q4 + rr) * NROUTE_PAD + nb * 16 + r16] = acc[nb][rr] * rs; }
            LDS_WAIT(); asm volatile("" ::: "memory");
            if (lane < 16) { const LAS float* L = lg + lane * NROUTE_PAD;
                float gmax = L[0]; int g = 0;
#pragma unroll
                for (int i = 1; i < NG; ++i) { const float v = L[i]; if (v > gmax) { gmax = v; g = i; } }
                float den = 0.f;
#pragma unroll
                for (int i = 0; i < NG; ++i) den += expf(L[i] - gmax);
                const float pg = 1.f / den; const LAS float* R = L + NG + g * EPG;
                float v0 = R[0]; int i0 = 0;
#pragma unroll
                for (int i = 1; i < EPG; ++i) { const float v = R[i]; if (v > v0) { v0 = v; i0 = i; } }
                float v1 = -3.0e38f; int i1 = (i0 == 0) ? 1 : 0;
#pragma unroll
                for (int i = 0; i < EPG; ++i) { const float v = R[i]; if (i != i0 && v > v1) { v1 = v; i1 = i; } }
                const float e1 = expf(v1 - v0), w0 = 1.f / (1.f + e1), w1 = e1 / (1.f + e1);
                const int ea = g * EPG + i0, eb = g * EPG + i1;
                const int pa = (int)__hip_atomic_fetch_add(cnt + ea * CNT_STRIDE, 1u, RLX_AGENT), pb = (int)__hip_atomic_fetch_add(cnt + eb * CNT_STRIDE, 1u, RLX_AGENT);
                v4u* rp = (v4u*)(recs + t0 + lane); rp[0] = (v4u){(unsigned)ea, (unsigned)eb, (unsigned)pa, (unsigned)pb};
                rp[1] = (v4u){__float_as_uint(pg * w0), __float_as_uint(pg * w1), 0u, 0u};
                const unsigned tk = (unsigned)(t0 + lane), rsb = __float_as_uint(rstd);
                lst[(size_t)ea * T + pa] = (v4u){tk, __float_as_uint(pg * w0), rsb, 0u}; lst[(size_t)eb * T + pb] = (v4u){tk, __float_as_uint(pg * w1), rsb, 0u}; }
        }
    }
}
__device__ __forceinline__ void build_tiles(Frame& F) {
    LAS int* ps = (LAS int*)(F.lds + LDS_PSTART); LAS int* te = (LAS int*)(F.lds + LDS_TE); const int lane = lane_id();
    __syncthreads();
    if (F.wave == 0) {
        const unsigned c = __hip_atomic_load((unsigned*)(F.ctl + CW_CNT) + lane * CNT_STRIDE, RLX_AGENT); const int n = (int)((c + 255u) >> 8);
        int inc = n;
#pragma unroll
        for (int o = 1; o < 64; o <<= 1) { const int v = __shfl_up(inc, o); if (lane >= o) inc += v; }
        const int t0 = inc - n;
        ps[lane] = t0 * 256; ps[128 + lane] = n; ps[192 + lane] = (int)c; if (lane == 63) ps[64] = inc;
        for (int k = 0; k < n; ++k) te[t0 + k] = lane; }
    __syncthreads();
}
__device__ __forceinline__ void build_rowtab(Frame& F, int nunits, int i0, int reps) {
    const LAS int* ps = (const LAS int*)(F.lds + LDS_PSTART); const LAS int* te = (const LAS int*)(F.lds + LDS_TE); LAS unsigned* tab = (LAS unsigned*)(F.lds + LDS_ROWTAB);
    const unsigned* lst = (const unsigned*)(F.ws + WS_LIST); const int tid = F.wave * 64 + lane_id();
#pragma unroll
    for (int q = 0; q < ROWTAB_UNITS * 256 / 512; ++q) { const int idx = tid + 512 * q, iu = idx >> 8, r = idx & 255; int L = (i0 + iu) * F.G + F.vcu;
        unsigned off = 0u;
        if (L < nunits * reps) { L %= nunits; const int tile = L >> 2, e = te[tile], pos = tile * 256 + r - ps[e];
            if (pos < ps[192 + e]) off = lst[((size_t)e * T + pos) * 4] * (unsigned)DM; }
        tab[idx] = off; }
    __syncthreads();
}
__device__ __forceinline__ void build_rowtab_chain(Frame& F, const pg8::ChainOrder& S) {
    const LAS int* ps = (const LAS int*)(F.lds + LDS_PSTART); const LAS int* te = (const LAS int*)(F.lds + LDS_TE); LAS unsigned* tab = (LAS unsigned*)(F.lds + LDS_ROWTAB);
    const unsigned* lst = (const unsigned*)(F.ws + WS_LIST); const int tid = F.wave * 64 + lane_id();
#pragma unroll
    for (int q = 0; q < ROWTAB_UNITS * 256 / 512; ++q) { const int idx = tid + 512 * q, iu = idx >> 8, r = idx & 255; pg8::Unit u; unsigned off = 0u;
        if (S.next(iu, u)) { const int e = te[u.pm], pos = u.pm * 256 + r - ps[e];
            if (u.kind == 0) { if (pos < ps[192 + e]) off = lst[((size_t)e * T + pos) * 4] * (unsigned)DM; }
            else off = (unsigned)(u.pm * 256 + r) * (unsigned)DE; }
        tab[idx] = off; }
    __syncthreads();
}
__device__ __forceinline__ void p10_combine(Frame& F, float* dst) {
    const int gw = F.vcu * 8 + F.wave, NGW = F.G * 8, lane = lane_id(); const LAS int* ps = (const LAS int*)(F.lds + LDS_PSTART);
    const unsigned char* YS = F.ws + WS_YS; const TokRec* recs = (const TokRec*)(F.ws + WS_TOK);
    for (int t0 = gw * 2; t0 < T; t0 += NGW * 2) {
        v4u r1[2]; f32x4 xv[2][4];
#pragma unroll
        for (int u = 0; u < 2; ++u) { r1[u] = *(const GAS v4u*)(recs + t0 + u); const GAS f32x4* o = (const GAS f32x4*)(F.out + (size_t)(t0 + u) * DM);
#pragma unroll
            for (int j = 0; j < 2; ++j) { xv[u][2 * j] = o[2 * (lane + 64 * j)]; xv[u][2 * j + 1] = o[2 * (lane + 64 * j) + 1]; } }
        typedef unsigned v2u_ __attribute__((ext_vector_type(2))); v2u_ ya[2][2], yb[2][2];
#pragma unroll
        for (int u = 0; u < 2; ++u) { const GAS v2u_* y0 = (const GAS v2u_*)(YS + (size_t)(ps[(int)r1[u].x] + (int)r1[u].z) * DM); const GAS v2u_* y1 = (const GAS v2u_*)(YS + (size_t)(ps[(int)r1[u].y] + (int)r1[u].w) * DM);
#pragma unroll
            for (int j = 0; j < 2; ++j) { ya[u][j] = y0[lane + 64 * j]; yb[u][j] = y1[lane + 64 * j]; } }
#pragma unroll
        for (int u = 0; u < 2; ++u) { GAS f32x4* o = (GAS f32x4*)(dst + (size_t)(t0 + u) * DM);
#pragma unroll
            for (int j = 0; j < 2; ++j) { const v2u_ a = ya[u][j], b = yb[u][j]; f32x4 p = xv[u][2 * j], q = xv[u][2 * j + 1];
                const auto a0 = __builtin_amdgcn_cvt_pk_f32_fp8((int)a.x, false), a1 = __builtin_amdgcn_cvt_pk_f32_fp8((int)a.x, true), a2 = __builtin_amdgcn_cvt_pk_f32_fp8((int)a.y, false), a3 = __builtin_amdgcn_cvt_pk_f32_fp8((int)a.y, true);
                const auto b0 = __builtin_amdgcn_cvt_pk_f32_fp8((int)b.x, false), b1 = __builtin_amdgcn_cvt_pk_f32_fp8((int)b.x, true), b2 = __builtin_amdgcn_cvt_pk_f32_fp8((int)b.y, false), b3 = __builtin_amdgcn_cvt_pk_f32_fp8((int)b.y, true);
                p.x += (a0[0] + b0[0]) * 0.0625f; p.y += (a0[1] + b0[1]) * 0.0625f; p.z += (a1[0] + b1[0]) * 0.0625f; p.w += (a1[1] + b1[1]) * 0.0625f;
                q.x += (a2[0] + b2[0]) * 0.0625f; q.y += (a2[1] + b2[1]) * 0.0625f; q.z += (a3[0] + b3[0]) * 0.0625f; q.w += (a3[1] + b3[1]) * 0.0625f;
                o[2 * (lane + 64 * j)] = p; o[2 * (lane + 64 * j) + 1] = q; } }
    }
}

constexpr int NPHASE = 11;
__device__ __forceinline__ const float* lds_arg(LAS unsigned char* lds, int k) { const volatile LAS unsigned* p = (const volatile LAS unsigned*)(lds + ARGS_OFF) + 2 * k;
    const unsigned lo = __builtin_amdgcn_readfirstlane(p[0]), hi = __builtin_amdgcn_readfirstlane(p[1]);
    return (const float*)(const __attribute__((address_space(1))) float*)(((unsigned long long)hi << 32) | lo); }
struct Args { const float* in[15]; float* out; unsigned char* ws; int ph_lo, ph_hi; int bar_region, pad; };
__global__ void __launch_bounds__(512, 2) fwd_kernel(Args args) {
    extern __shared__ __attribute__((aligned(16))) unsigned char lds[];
    Frame F;
    F.lds = (LAS unsigned char*)lds;
    F.MISC = (volatile LAS unsigned*)(F.lds + MISC_OFF);
    F.wave = __builtin_amdgcn_readfirstlane((int)threadIdx.x >> 6);
    F.G = gridDim.x; { const int bx = blockIdx.x; F.vcu = (F.G % 8 == 0) ? (bx % 8) * (F.G / 8) + bx / 8 : bx; }
    F.ws = args.ws; F.ctl = (gu32*)(args.ws + WS_CTL); F.out = args.out;
    for (int u = threadIdx.x; u < (LDS_BYTES - LDSCTL_OFF) / 4; u += 512) ((LAS unsigned*)(F.lds + LDSCTL_OFF))[u] = 0u;
    __syncthreads();
    if (threadIdx.x < 15) ((LAS unsigned long long*)(F.lds + ARGS_OFF))[threadIdx.x] = (unsigned long long)args.in[threadIdx.x];
    __syncthreads();
#define INP(k) lds_arg(F.lds, (k))
    const int lo = args.ph_lo, hi = args.ph_hi;
    const bool multi = (hi - lo) > 1;
    XcdBarrier bar; bar.wave = F.wave; bar.bar = (unsigned*)(F.ctl + CW_BAR) + args.bar_region * XCD_BAR_WORDS; bar.x = 0; bar.st = nullptr;
    if (multi) bar = xcd_barrier_post((unsigned*)(F.ctl + CW_BAR) + args.bar_region * XCD_BAR_WORDS, F.MISC + 8, F.wave);
#define IN(k) (lo <= (k) && (k) < hi)
#define SEAM(k) do { if (IN(k) && IN((k) + 1)) xcd_barrier(bar); } while (0)
#ifndef MK_REP_MASK
#define MK_REP_MASK 0
#endif
#define REPS(k) for (int rep_ = 0; rep_ < (((MK_REP_MASK >> (k)) & 1) ? 2 : 1); ++rep_)
#define REPBAR() do { if (rep_) xcd_barrier(bar); } while (0)
#define REPK(k) (((MK_REP_MASK >> (k)) & 1) ? 2 : 1)
    unsigned char* ws = args.ws;

    const bool p01 = (F.G == 256) && IN(0) && IN(1) && IN(2) && (MK_REP_MASK & 0x3) == 0;
    if (IN(0)) REPS(0) { REPBAR(); p0_prologue(F, INP(0), INP(1), INP(2), INP(6), INP(7), INP(8), INP(10), INP(11), p01 ? 1 : 0, 0, 0); } SEAM(0);
    if (IN(1)) {
        pg8::Gemm g{(const pg8::bf16_t*)(ws + WS_R1), (const pg8::bf16_t*)(ws + WS_WIN), T, DIN, DM}; pg8::StaticOrder S; S.init(T, DIN, F.G, (int)blockIdx.x, REPK(1));
        pg8::EpiProj E{ws, INP(4), INP(5), (LAS float*)(F.lds + LDS_ROWTAB)};
        pg8::gemm_phase<pg8::EpiProj, pg8::StaticOrder, true, true>(F.lds, g, S, E, F.wave);
        if (p01 && (int)blockIdx.x >= 128) { __syncthreads(); p0_prologue(F, INP(0), INP(1), INP(2), INP(6), INP(7), INP(8), INP(10), INP(11), 2, ((int)blockIdx.x - 128) * 8 + F.wave, 1024); }
    } SEAM(1);
    if (IN(2)) REPS(2) { REPBAR(); p2_elementwise(F, INP(3)); }
    do { if (IN(2) && !IN(3) && IN(4)) xcd_barrier(bar); } while (0);
    if (IN(3)) {
        PrepHook hk{INP(12), INP(13), INP(14), ws, F.lds, F.vcu * 8 + F.wave, F.G * 8, 0, (unsigned)(PREP_OFF + F.wave * PREP_BYTES)};
        NoHook nohk; bool fast_sm;
        { const int l_ = lane_id(); float gq = fmaxf(fabsf(INP(4)[l_]), fabsf(INP(4)[l_ + 64])), gk = fmaxf(fabsf(INP(5)[l_]), fabsf(INP(5)[l_ + 64]));
#pragma unroll
          for (int o_ = 1; o_ < 64; o_ <<= 1) { gq = fmaxf(gq, __shfl_xor(gq, o_)); gk = fmaxf(gk, __shfl_xor(gk, o_)); }
          const float bound_log2 = attn::SCALE * 128.f * gq * gk * 1.02f * 1.4426950408889634f;
          fast_sm = __builtin_amdgcn_readfirstlane(!(bound_log2 < 64.f) ? 0 : 1) != 0; }
        for (int un_ = F.vcu; un_ < BATCH * NH * (SEQ / 256) * REPK(3); un_ += F.G) { const int un = un_ & 511;
            const int pair = un >> 6, idx = un & 63, b = pair >> 1, kvh = pair & 1, h = kvh * 4 + (idx >> 4), qb = idx & 15;
            const size_t row0 = (size_t)b * SEQ;
            if (fast_sm) attn::attn_dense_body<true>((const attn::bf16*)(ws + WS_Q) + (row0 + (size_t)qb * 256) * 1024 + h * 128, (const attn::bf16*)(ws + WS_K) + row0 * 256 + kvh * 128,
                                  (const attn::bf16*)(ws + WS_V) + row0 * 256 + kvh * 128, (attn::bf16*)(ws + WS_ATTO) + (row0 + (size_t)qb * 256) * 1024 + h * 128, SEQ, (char*)lds, hk, F.wave);
            else attn::attn_dense_body<false>((const attn::bf16*)(ws + WS_Q) + (row0 + (size_t)qb * 256) * 1024 + h * 128, (const attn::bf16*)(ws + WS_K) + row0 * 256 + kvh * 128,
                                  (const attn::bf16*)(ws + WS_V) + row0 * 256 + kvh * 128, (attn::bf16*)(ws + WS_ATTO) + (row0 + (size_t)qb * 256) * 1024 + h * 128, SEQ, (char*)lds, nohk, F.wave);
            __syncthreads();
        }
        VM_WAIT(); __syncthreads();
        for (int it = hk.first + (hk.s >> 2) * hk.stride; it < NITEMS_E; it += hk.stride) { const ExpertItem d = expert_item(it, INP(12), INP(13), INP(14), ws); hk.whole(d, lane_id()); }
        __syncthreads();
    } SEAM(3);
    if (IN(4)) {
        pg8::Gemm g{(const pg8::bf16_t*)(ws + WS_R1), (const pg8::bf16_t*)(ws + WS_WC), 2 * T, 2 * DM, DM}; pg8::PairOrder S; S.so.init(T, DM, F.G, (int)blockIdx.x, REPK(4));
        pg8::EpiPair E{pg8::EpiPlain{(pg8::bf16_t*)(ws + WS_YCONV), DM}, pg8::EpiMerge{(const pg8::bf16_t*)(ws + WS_GC), (const pg8::bf16_t*)(ws + WS_GA), (const pg8::bf16_t*)(ws + WS_YCONV), (pg8::bf16_t*)(ws + WS_MERGED)}};
        pg8::gemm_phase<pg8::EpiPair, pg8::PairOrder, true, true>(F.lds, g, S, E, F.wave);
    } SEAM(4);
    const bool p56 = (F.G == 256) && IN(5) && IN(6) && (MK_REP_MASK & 0x60) == 0;
    if (IN(5)) {
        pg8::Gemm g{(const pg8::bf16_t*)(ws + WS_MERGED), (const pg8::bf16_t*)(ws + WS_WO), T, DM, DM}; pg8::StaticOrder S; S.init(T, DM, F.G, (int)blockIdx.x, REPK(5));
        pg8::EpiResid E{INP(0), F.out, p56};
        pg8::gemm_phase<pg8::EpiResid, pg8::StaticOrder, true, true>(F.lds, g, S, E, F.wave);
        if (p56) { pg8::Unit u5; if (S.next(0, u5)) {
            gu32* pc = F.ctl + CW_PANEL + 64 * u5.pm;
            asm volatile("s_waitcnt vmcnt(0)" ::: "memory"); __syncthreads();
            if (F.wave == 0 && lane_id() == 0) { (void)__hip_atomic_fetch_add((unsigned*)pc, 1u, RLX_AGENT);
                unsigned sp = 0; while (__hip_atomic_load((unsigned*)pc, RLX_AGENT) < 4u) { __builtin_amdgcn_s_sleep(2); if (++sp > (1u << 22)) break; }
                __builtin_amdgcn_fence(__ATOMIC_ACQUIRE, "agent"); asm volatile("s_waitcnt vmcnt(0)" ::: "memory"); }
            __syncthreads();
            p6_route(F, INP(9), u5.pm * 4 + u5.pn, T / 64); } }
    } do { if (IN(5) && IN(6) && !p56) xcd_barrier(bar); } while (0);
    if (IN(6) && !p56) REPS(6) { if (rep_) { xcd_barrier(bar); if (blockIdx.x == 0 && F.wave == 0) __hip_atomic_store((unsigned*)(F.ctl + CW_CNT) + lane_id() * CNT_STRIDE, 0u, RLX_AGENT); xcd_barrier(bar); }
        p6_route(F, INP(9), F.vcu, F.G); } do { if (IN(6) && IN(8)) xcd_barrier(bar); } while (0);
    const bool moe_chain = (F.G == 256) && IN(8) && IN(9) && (MK_REP_MASK & 0x300) == 0;
    if (moe_chain) {
        build_tiles(F);
        const int nt = ((const LAS int*)(F.lds + LDS_PSTART))[64];
        pg8::ChainOrder S{nt, F.G, F.vcu, (const LAS int*)(F.lds + LDS_TE), (unsigned*)(F.ctl + CW_TILERDY), (unsigned*)(F.ctl + CW_BAR) + XB_TMO, F.wave == 0};
        build_rowtab_chain(F, S);
        pg8::Gemm g{(const pg8::bf16_t*)(ws + WS_R1), (const pg8::bf16_t*)(ws + WS_W13), 0, 0, DM / 2, (const pg8::bf16_t*)(ws + WS_H), (const pg8::bf16_t*)(ws + WS_W2), DE / 2};
        pg8::EpiChain E{pg8::EpiSwiGLU{(pg8::bf16_t*)(ws + WS_H), (const unsigned*)(ws + WS_LIST), (const LAS int*)(F.lds + LDS_PSTART), true},
                        pg8::EpiMoeOut{(const unsigned*)(ws + WS_LIST), (const LAS int*)(F.lds + LDS_PSTART), (pg8::bf16_t*)(ws + WS_YS)}};
        pg8::gemm_phase<pg8::EpiChain, pg8::ChainOrder, true, true, true, true, true>(F.lds, g, S, E, F.wave, (const LAS unsigned*)(F.lds + LDS_ROWTAB));
        xcd_barrier(bar);
    }
    if ((IN(8) || IN(9)) && !moe_chain) {
        build_tiles(F);
        const int nt = ((const LAS int*)(F.lds + LDS_PSTART))[64];
        pg8::Gemm g{(const pg8::bf16_t*)(ws + WS_R1), (const pg8::bf16_t*)(ws + WS_W13), 0, 0, DM / 2, (const pg8::bf16_t*)(ws + WS_H), (const pg8::bf16_t*)(ws + WS_W2), DE / 2};
        pg8::EpiChain E{pg8::EpiSwiGLU{(pg8::bf16_t*)(ws + WS_H), (const unsigned*)(ws + WS_LIST), (const LAS int*)(F.lds + LDS_PSTART), true},
                        pg8::EpiMoeOut{(const unsigned*)(ws + WS_LIST), (const LAS int*)(F.lds + LDS_PSTART), (pg8::bf16_t*)(ws + WS_YS)}};
        for (int pass = 1; pass <= 2; ++pass) {
            if (pass == 2 && IN(8) && IN(9)) xcd_barrier(bar);
            if (!IN(7 + pass)) continue;
            for (int i0 = 0; i0 * F.G + F.vcu < nt * 4; i0 += ROWTAB_UNITS) {
                pg8::ChainOrder S{nt, F.G, F.vcu, (const LAS int*)(F.lds + LDS_TE), (unsigned*)(F.ctl + CW_TILERDY), (unsigned*)(F.ctl + CW_BAR) + XB_TMO, F.wave == 0, pass, i0, ROWTAB_UNITS};
                build_rowtab_chain(F, S);
                pg8::gemm_phase<pg8::EpiChain, pg8::ChainOrder, true, true, true, true, true>(F.lds, g, S, E, F.wave, (const LAS unsigned*)(F.lds + LDS_ROWTAB));
                __syncthreads();
            }
        }
    } do { if (IN(9) && IN(10) && !moe_chain) xcd_barrier(bar); } while (0);
    if (IN(10)) REPS(10) { REPBAR(); if (!IN(8)) build_tiles(F); p10_combine(F, (((MK_REP_MASK >> 10) & 1) && rep_ == 0) ? (float*)(ws + WS_GC) : F.out); }
#undef IN
#undef SEAM
}

#ifndef MK_ONE_LAUNCH
#define MK_ONE_LAUNCH 1
#endif
extern "C" void kernel_launch(void* const* d_in, const int* in_sizes, int n_in, void* d_out, int out_size, void* d_ws, size_t ws_size, hipStream_t stream) {
    static int grid = 0;
    if (grid == 0) {
        if (n_in != 15 || in_sizes[0] != T * DM || out_size != T * DM || ws_size < WS_END) { fprintf(stderr, "kernel_launch: shape/workspace mismatch (n_in %d, in0 %d, out %d, ws %zu, need %zu)\n", n_in, n_in > 0 ? in_sizes[0] : -1, out_size, ws_size, (size_t)WS_END); grid = -1; return; }
        int dev = 0, cus = 0, per_cu = 0;
        if (hipGetDevice(&dev) != hipSuccess || hipDeviceGetAttribute(&cus, hipDeviceAttributeMultiprocessorCount, dev) != hipSuccess) { grid = -1; return; }
        if (hipFuncSetAttribute((const void*)fwd_kernel, hipFuncAttributeMaxDynamicSharedMemorySize, LDS_BYTES) != hipSuccess) { fprintf(stderr, "kernel_launch: hipFuncSetAttribute failed\n"); grid = -1; return; }
        if (hipOccupancyMaxActiveBlocksPerMultiprocessor(&per_cu, (const void*)fwd_kernel, 512, LDS_BYTES) != hipSuccess || per_cu < 1) { fprintf(stderr, "kernel_launch: occupancy query says %d blocks per CU\n", per_cu); (void)hipGetLastError(); grid = -1; return; }
        grid = cus;
    }
    if (grid < 0) return;
    (void)hipMemsetAsync((char*)d_ws + WS_CTL, 0, CTL_ZERO_BYTES, stream);
    Args a{};
    for (int i = 0; i < 15; ++i) a.in[i] = (const float*)d_in[i];
    a.out = (float*)d_out; a.ws = (unsigned char*)d_ws;
#if MK_ONE_LAUNCH
    a.ph_lo = 0; a.ph_hi = NPHASE;
    hipLaunchKernelGGL(fwd_kernel, dim3(grid), dim3(512), LDS_BYTES, stream, a);
#ifdef MK_RERUN_HI
    a.ph_lo = MK_RERUN_LO; a.ph_hi = MK_RERUN_HI; a.bar_region = 1;
    hipLaunchKernelGGL(fwd_kernel, dim3(grid), dim3(512), LDS_BYTES, stream, a);
#endif
#else
    for (int p = 0; p < NPHASE; ++p) { a.ph_lo = p; a.ph_hi = p + 1; hipLaunchKernelGGL(fwd_kernel, dim3(grid), dim3(512), LDS_BYTES, stream, a); }
#endif
    const hipError_t le = hipPeekAtLastError();
    if (le != hipSuccess) fprintf(stderr, "kernel_launch: launch failed: %s\n", hipGetErrorName(le));
}
```

```cpp
#include <hip/hip_runtime.h>
#include <hip/hip_bf16.h>
#include <cstdio>
#include <cstdint>

__device__ __forceinline__ void cvt8_fp8(const float (&v)[8], unsigned& w0, unsigned& w1) {
    int a = 0, b = 0; a = __builtin_amdgcn_cvt_pk_fp8_f32(v[0], v[1], a, false); a = __builtin_amdgcn_cvt_pk_fp8_f32(v[2], v[3], a, true);
    b = __builtin_amdgcn_cvt_pk_fp8_f32(v[4], v[5], b, false); b = __builtin_amdgcn_cvt_pk_fp8_f32(v[6], v[7], b, true); w0 = (unsigned)a; w1 = (unsigned)b; }
__device__ __forceinline__ void cvt8_fp8_x32(const float (&v)[8], unsigned& w0, unsigned& w1) {
    typedef short v2s_ __attribute__((ext_vector_type(2))); v2s_ a = {0, 0}, b = {0, 0};
    a = __builtin_amdgcn_cvt_scalef32_pk_fp8_f32(a, v[0], v[1], 0.03125f, false); a = __builtin_amdgcn_cvt_scalef32_pk_fp8_f32(a, v[2], v[3], 0.03125f, true);
    b = __builtin_amdgcn_cvt_scalef32_pk_fp8_f32(b, v[4], v[5], 0.03125f, false); b = __builtin_amdgcn_cvt_scalef32_pk_fp8_f32(b, v[6], v[7], 0.03125f, true);
    w0 = __builtin_bit_cast(unsigned, a); w1 = __builtin_bit_cast(unsigned, b); }
constexpr int BATCH = 4, SEQ = 4096, DM = 1024, T = BATCH * SEQ;
constexpr int NH = 8, NKV = 2, HD = 128, DKV = NKV * HD;
constexpr int DIN = 6656;
constexpr int NG = 8, EPG = 8, NE = 64, DE = 512;
constexpr int NROUTE = 72, NROUTE_PAD = 80;
constexpr int MAXTILES = 192;
constexpr float EPS = 1e-6f;

constexpr size_t MiB = 1u << 20;
constexpr size_t WS_CTL = 0, CTL_ZERO_BYTES = 160 * 1024;
constexpr size_t WS_ROPE = 1 * MiB;
constexpr size_t WS_WRT  = 1 * MiB + 64 * 1024;
constexpr size_t WS_TOK  = 2 * MiB;
constexpr size_t WS_ROWW = 3 * MiB;
constexpr size_t WS_ROWRS = 3 * MiB + 256 * 1024;
constexpr size_t WS_TRS  = 2 * MiB + 512 * 1024;
constexpr size_t WS_WIN  = 4 * MiB;
constexpr size_t WS_WC   = 18 * MiB, WS_WA = 20 * MiB, WS_WO = 22 * MiB;
constexpr size_t WS_W13  = 24 * MiB;
constexpr size_t WS_W2   = 152 * MiB;
constexpr size_t WS_R1   = 216 * MiB;
constexpr size_t SEG = 32 * MiB;
constexpr size_t WS_CB   = 248 * MiB, WS_CC = WS_CB + SEG, WS_CX = WS_CC + SEG;
constexpr size_t WS_Q    = WS_CX + SEG;
constexpr size_t WS_K    = WS_Q + SEG, WS_V = WS_K + 8 * MiB;
constexpr size_t WS_GC   = WS_V + 8 * MiB, WS_GA = WS_GC + SEG;
constexpr size_t WS_END  = WS_GA + 2 * SEG;
constexpr size_t WS_ATTO = WS_GA + SEG;
constexpr size_t WS_U8 = WS_CX;
constexpr int N8_0 = 3072;
constexpr size_t WS_W8 = WS_WIN + (size_t)N8_0 * 2048;
constexpr size_t WS_YCONV = WS_CC, WS_MERGED = WS_CX;
constexpr int ATTO_PM = (int)((WS_ATTO - WS_R1) / (256 * 1024 * 2));
static_assert((WS_ATTO - WS_R1) % (256 * 1024 * 2) == 0 && WS_ATTO + SEG <= 512 * MiB && WS_WC + 2 * MiB == WS_WA, "operands of the paired GEMM stream; workspace size");
constexpr size_t WS_LIST = WS_GC;
constexpr size_t WS_H    = WS_Q;
constexpr size_t WS_YS   = WS_CB;
static_assert(WS_WIN + (size_t)DIN * DM * 2 <= WS_WC && WS_W13 + (size_t)NE * 1024 * 1024 * 2 == WS_W2 && WS_W2 + (size_t)NE * 1024 * 512 * 2 == WS_R1, "ws map");
static_assert((size_t)MAXTILES * 256 * 1024 * 2 == 3 * SEG && (size_t)MAXTILES * 256 * 512 * 2 == SEG + 16 * MiB, "overlay sizes");
constexpr int CW_CNT = 16384, CNT_STRIDE = 64;
constexpr int CW_PANEL = 12288;
constexpr int CW_TILERDY = 20480;
static_assert((CW_TILERDY + 64 * MAXTILES) * 4 <= (int)CTL_ZERO_BYTES, "control words inside the per-call memset");
constexpr int CW_BAR = 4096;
static_assert((CW_CNT + 64 * CNT_STRIDE) * 4 <= (int)CTL_ZERO_BYTES && (CW_BAR + 2 * 3456) * 4 <= CW_CNT * 4, "control words inside the per-call memset");

constexpr int RING_BYTES = 131072;
constexpr int PREP_OFF = 67584, PREP_BYTES = 8192;
constexpr int LDSCTL_OFF = 135168;
static_assert(PREP_OFF + 8 * PREP_BYTES <= LDSCTL_OFF && RING_BYTES <= LDSCTL_OFF, "LDS map");
constexpr int MISC_OFF = LDSCTL_OFF + 320;
constexpr int ARGS_OFF = LDSCTL_OFF + 512;
constexpr int LDS_PSTART = LDSCTL_OFF + 1024;
constexpr int LDS_TE = LDS_PSTART + 1024;
constexpr int LDS_ROWTAB = LDS_TE + MAXTILES * 4, ROWTAB_UNITS = 8;
constexpr int LDS_ROWSC = LDS_ROWTAB + ROWTAB_UNITS * 1024;
constexpr int LDS_BYTES = 155648;
static_assert(LDS_ROWSC + ROWTAB_UNITS * 1024 <= LDS_BYTES && LDS_BYTES <= 160 * 1024, "LDS map");

namespace pg8 {
#define PG8_LAS __attribute__((address_space(3)))
typedef unsigned short bf16_t;
typedef short bf16x8 __attribute__((ext_vector_type(8)));
typedef float f32x4 __attribute__((ext_vector_type(4)));
typedef unsigned u32x4 __attribute__((ext_vector_type(4)));
constexpr int BM = 256, BK = 64, HALF = 128, HTB = HALF * BK * 2  , STAGE_BYTES = 8 * HTB, NXCD = 8, WGM = 4;

__host__ __device__ __forceinline__ int lds_byte(int r, int c) { const int st = (r >> 4) * 2 + (c >> 5), rr = r & 15, cc = c & 31, ob = rr * 64 + cc * 2; return st * 1024 + (ob ^ (((ob >> 9) & 1) << 5)); }
__host__ __device__ __forceinline__ void stage_rc(int b, int& R, int& C) { const int st = b / 1024, sb = b % 1024, swz = sb ^ (((sb >> 9) & 1) << 5); R = (st >> 1) * 16 + swz / 64; C = (st & 1) * 32 + (swz % 64) / 2; }
__host__ __device__ __forceinline__ int perm32(int rho) { const int n = rho >> 4, i = rho & 15; return 8 * (i >> 2) + 4 * n + (i & 3); }

struct Unit { int pm, pn, kind; int ui = 0; };
struct Gemm { const bf16_t* A; const bf16_t* Bt; int M, N, K; const bf16_t* A1 = nullptr; const bf16_t* Bt1 = nullptr; int K1 = 0; };

struct StaticOrder {
    int nM, nN, nwg, G, c, reps;
    __host__ __device__ void init(int M, int N, int G_, int c_, int reps_ = 1) { nM = M / BM; nN = N / BM; nwg = nM * nN; G = G_; c = c_; reps = reps_; }
    __host__ __device__ __forceinline__ bool next(int i, Unit& u) const {
        const long L = (long)i * G + c; if (L >= (long)nwg * reps) return false;
        int wgid = (int)(L % nwg); { const int q = nwg / NXCD, r = nwg % NXCD, xcd = wgid % NXCD, off = wgid / NXCD; wgid = (xcd < r ? xcd * (q + 1) : r * (q + 1) + (xcd - r) * q) + off; }
        const int nig = WGM * nN, gid = wgid / nig, fm = gid * WGM, gsz = (nM - fm) < WGM ? (nM - fm) : WGM;
        u.pm = fm + ((wgid % nig) % gsz); u.pn = (wgid % nig) / gsz; u.kind = 0; return true;
    }
    __device__ __forceinline__ void a_ready(const Unit&) const {}
    __device__ __forceinline__ void done(const Unit&) const {}
};

__device__ __forceinline__ unsigned cvt_pk_bf16(float lo, float hi) { unsigned r; asm volatile("v_cvt_pk_bf16_f32 %0, %1, %2" : "=v"(r) : "v"(lo), "v"(hi)); return r; }
__device__ __forceinline__ float bf_lo(unsigned w) { return __uint_as_float(w << 16); }
__device__ __forceinline__ float bf_hi(unsigned w) { return __uint_as_float(w & 0xffff0000u); }
__device__ __forceinline__ float sigmoidf_(float x) { return __builtin_amdgcn_rcpf(1.0f + __expf(-x)); }
__device__ __forceinline__ u32x4 pack8(const f32x4 v0, const f32x4 v1) { u32x4 w; w.x = cvt_pk_bf16(v0[0], v0[1]); w.y = cvt_pk_bf16(v0[2], v0[3]); w.z = cvt_pk_bf16(v1[0], v1[1]); w.w = cvt_pk_bf16(v1[2], v1[3]); return w; }

__device__ __forceinline__ void st8_wt(void* p, unsigned w0, unsigned w1) { typedef unsigned u32x2_ __attribute__((ext_vector_type(2))); const u32x2_ v = {w0, w1}; asm volatile("global_store_dwordx2 %0, %1, off sc1\n\ts_nop 1" :: "v"(p), "v"(v) : "memory"); }
__device__ __forceinline__ void st16_wt(void* p, const u32x4 v) { asm volatile("global_store_dwordx4 %0, %1, off sc1\n\ts_nop 1" :: "v"(p), "v"(v) : "memory"); }
struct EpiPlain {
    static constexpr bool PERM = true, AFTER_DRAIN = false;
    bf16_t* O; int ldc;
    __device__ __forceinline__ void operator()(const f32x4 (&acc)[2][2][4][2], const Unit& u, int wr, int wc, int fr, int fq) const {
        const int row0 = u.pm * BM + wr * 64 + fr, col0 = u.pn * BM + wc * 32 + 8 * fq;
#pragma unroll
        for (int ai = 0; ai < 2; ++ai)
#pragma unroll
            for (int m = 0; m < 4; ++m) { bf16_t* rowp = O + (size_t)(row0 + ai * HALF + m * 16) * ldc + col0;
#pragma unroll
                for (int bj = 0; bj < 2; ++bj) *(u32x4*)(rowp + bj * HALF) = pack8(acc[ai][bj][m][0], acc[ai][bj][m][1]); }
    }
};
struct EpiProj {
    static constexpr bool PERM = true, AFTER_DRAIN = false;
    unsigned char* ws; const float* qg; const float* kg; PG8_LAS float* xch; float gs = 1.f;
    __device__ __forceinline__ void operator()(const f32x4 (&acc)[2][2][4][2], const Unit& u, int wr, int wc, int fr, int fq) const {
        const int pn = u.pn; size_t off; int ldc, colt; bool sig = false;
        if (pn < 12)       { off = WS_CB + (size_t)(pn >> 2) * SEG; ldc = 1024; colt = (pn & 3) * 256; }
        else if (pn < 16)  { off = WS_Q; ldc = 1024; colt = (pn - 12) * 256; }
        else if (pn == 16) { off = WS_K; ldc = 256; colt = 0; }
        else if (pn == 17) { off = WS_V; ldc = 256; colt = 0; }
        else               { off = WS_GC + (size_t)((pn - 18) >> 2) * SEG; ldc = 1024; colt = ((pn - 18) & 3) * 256; sig = true; }
        bf16_t* base = (bf16_t*)(ws + off);
        const int row0 = u.pm * BM + wr * 64 + fr, col0 = colt + wc * 32 + 8 * fq;
        if (pn >= 4 && pn < 12) {
            bf16_t* P = (bf16_t*)(ws + WS_CC); const int pc0 = (pn - 4) * 128 + wc * 32 + 8 * fq;
#pragma unroll
            for (int ai = 0; ai < 2; ++ai)
#pragma unroll
                for (int m = 0; m < 4; ++m) *(u32x4*)(P + (size_t)(row0 + ai * HALF + m * 16) * 1024 + pc0) = pack8(acc[ai][0][m][0] * acc[ai][1][m][0], acc[ai][0][m][1] * acc[ai][1][m][1]);
            return;
        }
        if (pn >= 12 && pn <= 16) {
#pragma unroll
            for (int ai = 0; ai < 2; ++ai)
#pragma unroll
                for (int m = 0; m < 4; ++m)
#pragma unroll
                    for (int bj = 0; bj < 2; ++bj) { const f32x4 a = acc[ai][bj][m][0], b = acc[ai][bj][m][1];
                        float s = (a[0] * a[0] + a[1] * a[1]) + (a[2] * a[2] + a[3] * a[3]) + (b[0] * b[0] + b[1] * b[1]) + (b[2] * b[2] + b[3] * b[3]);
                        s += __shfl_xor(s, 16); s += __shfl_xor(s, 32);
                        if (fq == 0) xch[((ai * HALF + wr * 64 + m * 16 + fr) * 2 + bj) * 4 + wc] = s; }
            asm volatile("s_waitcnt lgkmcnt(0)" ::: "memory"); __builtin_amdgcn_s_barrier(); asm volatile("" ::: "memory");
            const float* gam = (pn == 16 ? kg : qg) + wc * 32 + 8 * fq;
            const f32x4 g0 = *(const f32x4*)gam, g1 = *(const f32x4*)(gam + 4);
            const float* ct = (const float*)(ws + WS_ROPE); const float* st = ct + 2048; const int j0 = 16 * (wc & 1) + 4 * fq;
            f32x4 cs[2][2];
#define EP_ROPE(k) do { const int rl_ = ((k) >> 2) * HALF + wr * 64 + ((k) & 3) * 16 + fr, sq_ = (u.pm * BM + rl_) & (SEQ - 1), pos_ = (wc < 2) ? (sq_ >> 6) : (sq_ & 63); \
                cs[(k) & 1][0] = *(const f32x4*)(ct + pos_ * 32 + j0); cs[(k) & 1][1] = *(const f32x4*)(st + pos_ * 32 + j0); } while (0)
            EP_ROPE(0);
#pragma unroll
            for (int k = 0; k < 8; ++k) { const int ai = k >> 2, m = k & 3;
                { const int rl = ai * HALF + wr * 64 + m * 16 + fr, r = u.pm * BM + rl;
                    if (k < 7) EP_ROPE(k + 1);
                    const f32x4 c4 = cs[k & 1][0], s4 = cs[k & 1][1];
                    unsigned char* rowp = (unsigned char*)base + (size_t)r * ldc + col0;
                    const float qs = (pn == 16) ? 1.f : 0.088388347648318440f * 1.4426950408889634f;
#pragma unroll
                    for (int bj = 0; bj < 2; ++bj) { const f32x4 p = *(const PG8_LAS f32x4*)(xch + (rl * 2 + bj) * 4);
                        const float rstd = 1.f / sqrtf(((p[0] + p[1]) + (p[2] + p[3])) * (1.f / 128.f) + EPS);
                        const f32x4 y0 = acc[ai][bj][m][0] * rstd * g0, y1 = acc[ai][bj][m][1] * rstd * g1; f32x4 o0, o1;
                        o0[0] = y0[0] * c4[0] - y0[1] * s4[0]; o0[1] = y0[0] * s4[0] + y0[1] * c4[0]; o0[2] = y0[2] * c4[1] - y0[3] * s4[1]; o0[3] = y0[2] * s4[1] + y0[3] * c4[1];
                        o1[0] = y1[0] * c4[2] - y1[1] * s4[2]; o1[1] = y1[0] * s4[2] + y1[1] * c4[2]; o1[2] = y1[2] * c4[3] - y1[3] * s4[3]; o1[3] = y1[2] * s4[3] + y1[3] * c4[3];
                        const float ov[8] = {o0[0] * qs, o0[1] * qs, o0[2] * qs, o0[3] * qs, o1[0] * qs, o1[1] * qs, o1[2] * qs, o1[3] * qs}; unsigned w0_, w1_; cvt8_fp8(ov, w0_, w1_);
                        typedef unsigned u32x2_ __attribute__((ext_vector_type(2))); const u32x2_ v2_ = {w0_, w1_}; *(u32x2_*)(rowp + bj * HALF) = v2_; } }
                asm volatile("" ::: "memory"); }
#undef EP_ROPE
            return;
        }
        if (pn == 17) {
#pragma unroll
            for (int ai = 0; ai < 2; ++ai)
#pragma unroll
                for (int m = 0; m < 4; ++m) { const int r = row0 + ai * HALF + m * 16, bq = r >> 12, key = r & (SEQ - 1);
#pragma unroll
                    for (int bj = 0; bj < 2; ++bj) { unsigned char* vt = ws + WS_V + ((size_t)((bq * 2 + bj) * 128 + wc * 32 + 8 * fq)) * SEQ + key;
#pragma unroll
                        for (int i = 0; i < 4; ++i) { const float a_ = acc[ai][bj][m][0][i] * gs, b_ = acc[ai][bj][m][1][i] * gs;
                            vt[(size_t)i * SEQ] = (unsigned char)__builtin_amdgcn_cvt_pk_fp8_f32(a_, a_, 0, false); vt[(size_t)(4 + i) * SEQ] = (unsigned char)__builtin_amdgcn_cvt_pk_fp8_f32(b_, b_, 0, false); } } }
            return; }
#pragma unroll
        for (int ai = 0; ai < 2; ++ai)
#pragma unroll
            for (int m = 0; m < 4; ++m) { bf16_t* rowp = base + (size_t)(row0 + ai * HALF + m * 16) * ldc + col0;
#pragma unroll
                for (int bj = 0; bj < 2; ++bj) { f32x4 v0 = acc[ai][bj][m][0], v1 = acc[ai][bj][m][1];
                    if (sig) {
#pragma unroll
                        for (int i = 0; i < 4; ++i) { v0[i] = sigmoidf_(v0[i] * gs); v1[i] = sigmoidf_(v1[i] * gs); } }
                    else { v0 *= gs; v1 *= gs; }
                    *(u32x4*)(rowp + bj * HALF) = pack8(v0, v1); } }
    }
};
struct EpiMerge {
    static constexpr bool PERM = true, AFTER_DRAIN = false;
    const bf16_t* gc; const bf16_t* ga; const bf16_t* yc; bf16_t* O; float as = 1.f;
    __device__ __forceinline__ void operator()(const f32x4 (&acc)[2][2][4][2], const Unit& u, int wr, int wc, int fr, int fq) const {
        const int row0 = u.pm * BM + wr * 64 + fr, col0 = u.pn * BM + wc * 32 + 8 * fq;
        u32x4 g1[2][2], g2[2][2], y[2][2];
#define EM_LOAD(k) do { _Pragma("unroll") for (int bj = 0; bj < 2; ++bj) { const size_t o = (size_t)(row0 + ((k) >> 2) * HALF + ((k) & 3) * 16) * 1024 + col0 + bj * HALF; \
            g1[(k) & 1][bj] = *(const u32x4*)(gc + o); g2[(k) & 1][bj] = *(const u32x4*)(ga + o); y[(k) & 1][bj] = *(const u32x4*)(yc + o); } } while (0)
        EM_LOAD(0);
#pragma unroll
        for (int k = 0; k < 8; ++k) { const int ai = k >> 2, m = k & 3;
            if (k < 7) EM_LOAD(k + 1);
#pragma unroll
            for (int bj = 0; bj < 2; ++bj) { const size_t o = (size_t)(row0 + ai * HALF + m * 16) * 1024 + col0 + bj * HALF;
                const u32x4 a = g1[k & 1][bj], b = g2[k & 1][bj], c = y[k & 1][bj]; const f32x4 a0 = acc[ai][bj][m][0] * as, a1 = acc[ai][bj][m][1] * as; f32x4 r0, r1;
                r0[0] = bf_lo(a.x) * bf_lo(c.x) + bf_lo(b.x) * a0[0]; r0[1] = bf_hi(a.x) * bf_hi(c.x) + bf_hi(b.x) * a0[1];
                r0[2] = bf_lo(a.y) * bf_lo(c.y) + bf_lo(b.y) * a0[2]; r0[3] = bf_hi(a.y) * bf_hi(c.y) + bf_hi(b.y) * a0[3];
                r1[0] = bf_lo(a.z) * bf_lo(c.z) + bf_lo(b.z) * a1[0]; r1[1] = bf_hi(a.z) * bf_hi(c.z) + bf_hi(b.z) * a1[1];
                r1[2] = bf_lo(a.w) * bf_lo(c.w) + bf_lo(b.w) * a1[2]; r1[3] = bf_hi(a.w) * bf_hi(c.w) + bf_hi(b.w) * a1[3];
                *(u32x4*)(O + o) = pack8(r0, r1); }
            asm volatile("" ::: "memory"); }
#undef EM_LOAD
    }
};
struct EpiPair {
    static constexpr bool PERM = true, AFTER_DRAIN = false;
    EpiPlain conv; EpiMerge mrg;
    __device__ __forceinline__ void operator()(const f32x4 (&acc)[2][2][4][2], const Unit& u, int wr, int wc, int fr, int fq) const {
        if (u.pn < 4) conv(acc, u, wr, wc, fr, fq);
        else { Unit v; v.pm = u.pm - ATTO_PM; v.pn = u.pn - 4; v.kind = 0; mrg(acc, v, wr, wc, fr, fq); }
    }
};
struct PairOrder {
    StaticOrder so;
    __device__ __forceinline__ bool next(int i, Unit& u) const { if (!so.next(i >> 1, u)) return false; const int st = i & 1; u.pm += ATTO_PM * st; u.pn += 4 * st; return true; }
    __device__ __forceinline__ void a_ready(const Unit&) const {}
    __device__ __forceinline__ void done(const Unit&) const {}
};
struct EpiResid {
    static constexpr bool PERM = false, AFTER_DRAIN = false;
    const float* x; float* out; bool wt;
    __device__ __forceinline__ void operator()(const f32x4 (&acc)[2][2][4][2], const Unit& u, int wr, int wc, int fr, int fq) const {
        const int row0 = u.pm * BM + wr * 64 + fr, col0 = u.pn * BM + wc * 32 + 4 * fq;
        f32x4 xv[2][2][2][2];
#define ER_LOAD(b) do { const int ai_ = (b) >> 1, mb_ = ((b) & 1) * 2; _Pragma("unroll") for (int mm = 0; mm < 2; ++mm) _Pragma("unroll") for (int bj = 0; bj < 2; ++bj) _Pragma("unroll") for (int n = 0; n < 2; ++n) \
            xv[(b) & 1][mm][bj][n] = *(const f32x4*)(x + (size_t)(row0 + ai_ * HALF + (mb_ + mm) * 16) * 1024 + col0 + bj * HALF + n * 16); } while (0)
        ER_LOAD(0);
#pragma unroll
        for (int b = 0; b < 4; ++b) { const int ai = b >> 1, mb = (b & 1) * 2;
            if (b < 3) ER_LOAD(b + 1);
#pragma unroll
            for (int mm = 0; mm < 2; ++mm)
#pragma unroll
                for (int bj = 0; bj < 2; ++bj)
#pragma unroll
                    for (int n = 0; n < 2; ++n) { const f32x4 r_ = xv[b & 1][mm][bj][n] + acc[ai][bj][mb + mm][n]; float* q_ = out + (size_t)(row0 + ai * HALF + (mb + mm) * 16) * 1024 + col0 + bj * HALF + n * 16;
                        if (wt) st16_wt(q_, __builtin_bit_cast(u32x4, r_)); else *(f32x4*)q_ = r_; }
            asm volatile("" ::: "memory"); }
#undef ER_LOAD
    }
};
struct EpiSwiGLU {
    static constexpr bool PERM = true, AFTER_DRAIN = false;
    bf16_t* H; const unsigned* lst; const PG8_LAS int* ps; bool wt; const PG8_LAS float* sc;
    __device__ __forceinline__ void operator()(const f32x4 (&acc)[2][2][4][2], const Unit& u, int wr, int wc, int fr, int fq) const {
        const int row0 = u.pm * BM + wr * 64 + fr, col0 = (u.pn & 3) * 128 + wc * 32 + 8 * fq; const int e = u.pn >> 2;
        const unsigned* le = lst + ((size_t)e * T + (size_t)(row0 - ps[e])) * 4 + 2;
        const PG8_LAS float* scu = sc + u.ui * 256 + wr * 64 + fr; float rsv[2][4];
#pragma unroll
        for (int ai = 0; ai < 2; ++ai)
#pragma unroll
            for (int m = 0; m < 4; ++m) rsv[ai][m] = scu[ai * HALF + m * 16];
#pragma unroll
        for (int ai = 0; ai < 2; ++ai)
#pragma unroll
            for (int m = 0; m < 4; ++m) { unsigned char* rowp = (unsigned char*)H + (size_t)(row0 + ai * HALF + m * 16) * 512 + col0; const float rs = rsv[ai][m] * 0.03125f;
                f32x4 h0, h1;
#pragma unroll
                for (int i = 0; i < 4; ++i) { const float a = acc[ai][0][m][0][i] * rs, b = acc[ai][1][m][0][i] * rs, c = acc[ai][0][m][1][i] * rs, d = acc[ai][1][m][1][i] * rs;
                    h0[i] = a * sigmoidf_(a) * b; h1[i] = c * sigmoidf_(c) * d; }
                const float hv[8] = {h0[0], h0[1], h0[2], h0[3], h1[0], h1[1], h1[2], h1[3]}; unsigned w0, w1; cvt8_fp8(hv, w0, w1);
                if (wt) st8_wt(rowp, w0, w1); else { typedef unsigned u32x2_ __attribute__((ext_vector_type(2))); const u32x2_ v2 = {w0, w1}; *(u32x2_*)rowp = v2; } }
    }
};
struct EpiMoeOut {
    static constexpr bool PERM = true, AFTER_DRAIN = false;
    const unsigned* lst; const PG8_LAS int* ps; bf16_t* YS; const PG8_LAS float* sc;
    __device__ __forceinline__ void operator()(const f32x4 (&acc)[2][2][4][2], const Unit& u, int wr, int wc, int fr, int fq) const {
        const int row0 = u.pm * BM + wr * 64 + fr, col0 = (u.pn & 3) * 256 + wc * 32 + 8 * fq; const int e = u.pn >> 2;
        const unsigned* le = lst + ((size_t)e * T + (size_t)(row0 - ps[e])) * 4 + 1;
        const PG8_LAS float* scu = sc + u.ui * 256 + wr * 64 + fr; float wv[2][4];
#pragma unroll
        for (int ai = 0; ai < 2; ++ai)
#pragma unroll
            for (int m = 0; m < 4; ++m) wv[ai][m] = scu[ai * HALF + m * 16];
#pragma unroll
        for (int ai = 0; ai < 2; ++ai)
#pragma unroll
            for (int m = 0; m < 4; ++m) { const int r = row0 + ai * HALF + m * 16; const float w = wv[ai][m] * 0.5f; unsigned char* rowp = (unsigned char*)YS + (size_t)r * 1024 + col0;
#pragma unroll
                for (int bj = 0; bj < 2; ++bj) { const f32x4 a0 = acc[ai][bj][m][0] * w, a1 = acc[ai][bj][m][1] * w; const float yv[8] = {a0[0], a0[1], a0[2], a0[3], a1[0], a1[1], a1[2], a1[3]};
                    unsigned w0, w1; cvt8_fp8(yv, w0, w1); typedef unsigned u32x2_ __attribute__((ext_vector_type(2))); const u32x2_ v2 = {w0, w1}; *(u32x2_*)(rowp + bj * HALF) = v2; } }
    }
};
struct MoeOrder {
    int nunits, G, c; const PG8_LAS int* te; int reps; int i0, imax;
    __device__ __forceinline__ bool next(int i, Unit& u) const {
        if (i >= imax) return false;
        int L = (i + i0) * G + c; if (L >= nunits * reps) return false; L %= nunits;
        const int tile = L >> 2; u.pm = tile; u.pn = te[tile] * 4 + (L & 3); u.kind = 0; return true; }
    __device__ __forceinline__ void a_ready(const Unit&) const {}
    __device__ __forceinline__ void done(const Unit&) const {}
};

struct ChainOrder {
    int nt, G, c; const PG8_LAS int* te; unsigned* ready; unsigned* tmo;
    __device__ __forceinline__ int su(int g) const { const int r = nt - 64 * g; return 4 * (r > 64 ? 64 : r); }
    __device__ __forceinline__ void mk(Unit& u, int g, int q, int kind) const { const int tile = 64 * g + (q >> 2); u.pm = tile; u.pn = te[tile] * 4 + (q & 3); u.kind = kind; }
    __device__ __forceinline__ bool decode(int pos, Unit& u) const {
        const int ng = (nt + 63) >> 6;
        if (pos < su(0)) { mk(u, 0, pos, 0); return true; } pos -= su(0);
        for (int g = 1; g < ng; ++g) { if (pos < su(g)) { mk(u, g, pos, 0); return true; } pos -= su(g); if (pos < su(g - 1)) { mk(u, g - 1, pos, 1); return true; } pos -= su(g - 1); }
        if (pos < su(ng - 1)) { mk(u, ng - 1, pos, 1); return true; }
        return false; }
    __device__ __forceinline__ bool next(int i, Unit& u) const {
        u.ui = i;
        if (mode == 0) return decode(i * G + c, u);
        if (i >= imax) return false;
        const int L = (i + i0) * G + c; if (L >= nt * 4) return false;
        const int tile = L >> 2; u.pm = tile; u.pn = te[tile] * 4 + (L & 3); u.kind = mode - 1; return true; }
    __device__ __forceinline__ void a_ready(const Unit& u) const {
        if (u.kind != 1 || mode != 0) return;
        int l; asm volatile("v_mbcnt_lo_u32_b32 %0, -1, 0\n\tv_mbcnt_hi_u32_b32 %0, -1, %0" : "=v"(l));
        if (__builtin_amdgcn_readfirstlane(l) == 0 && wave0) {
            unsigned sp = 0; while ((unsigned)__builtin_amdgcn_readfirstlane(__hip_atomic_load(ready + 64 * u.pm, __ATOMIC_RELAXED, __HIP_MEMORY_SCOPE_AGENT)) < 32u) { __builtin_amdgcn_s_sleep(2); if (++sp > (1u << 22)) { if (l == 0) __hip_atomic_store(tmo, 1u, __ATOMIC_RELAXED, __HIP_MEMORY_SCOPE_AGENT); break; } }
            asm volatile("s_waitcnt vmcnt(0)" ::: "memory"); }
        asm volatile("" ::: "memory"); __builtin_amdgcn_s_barrier(); asm volatile("" ::: "memory");
    }
    __device__ __forceinline__ void done(const Unit& u) const {
        if (u.kind != 0 || mode != 0) return;
        asm volatile("s_waitcnt vmcnt(0)" ::: "memory");
        int l; asm volatile("v_mbcnt_lo_u32_b32 %0, -1, 0\n\tv_mbcnt_hi_u32_b32 %0, -1, %0" : "=v"(l));
        if (l == 0) (void)__hip_atomic_fetch_add(ready + 64 * u.pm, 1u, __ATOMIC_RELAXED, __HIP_MEMORY_SCOPE_AGENT); }
    bool wave0; int mode = 0, i0 = 0, imax = 1 << 30;
};
struct EpiGate {
    static constexpr bool PERM = true, AFTER_DRAIN = false;
    EpiProj proj;
    __device__ __forceinline__ void operator()(const f32x4 (&acc)[2][2][4][2], const Unit& u, int wr, int wc, int fr, int fq) const { Unit v = u; v.pn = u.pn + 12; proj(acc, v, wr, wc, fr, fq); }
};
struct GateOrder {
    int G, c;
    __device__ __forceinline__ bool next(int i, Unit& u) const {
        int q;
        if (G == 256) { if (c < 128) { if (i > 3) return false; q = c * 4 + i; } else { if (i > 2) return false; q = 512 + (c - 128) * 3 + i; } }
        else { q = i * G + c; if (q >= 896) return false; }
        u.pm = q & 63; u.pn = q >> 6; u.kind = 0; u.ui = i; return true; }
    __device__ __forceinline__ void a_ready(const Unit&) const {}
    __device__ __forceinline__ void done(const Unit&) const {}
};
struct TileOrder {
    StaticOrder so;
    __device__ __forceinline__ bool next(int i, Unit& u) const { if (!so.next(i, u)) return false; u.ui = i; return true; }
    __device__ __forceinline__ void a_ready(const Unit&) const {}
    __device__ __forceinline__ void done(const Unit&) const {}
};
struct EpiChain {
    static constexpr bool PERM = true, AFTER_DRAIN = false;
    EpiSwiGLU up; EpiMoeOut down;
    __device__ __forceinline__ void operator()(const f32x4 (&acc)[2][2][4][2], const Unit& u, int wr, int wc, int fr, int fq) const { if (u.kind == 0) up(acc, u, wr, wc, fr, fq); else down(acc, u, wr, wc, fr, fq); }
};

template <class Epi, class Sched, bool ALIGN_EPI = false, bool SP2 = false, bool GATHER = false, bool HET = false, bool FP8 = false>
__device__ __forceinline__ void gemm_phase(PG8_LAS unsigned char* lds, const Gemm g, const Sched& S, const Epi& E, int wave_, const PG8_LAS unsigned* rowtab = nullptr) {
    int lane; asm volatile("v_mbcnt_lo_u32_b32 %0, -1, 0\n\tv_mbcnt_hi_u32_b32 %0, -1, %0" : "=v"(lane));
    const int wid = wave_, tid = wid * 64 + lane, wr = wid >> 2, wc = wid & 3, fr = lane & 15, fq = lane >> 4;
    const int K = g.K, nt = K / BK;
    unsigned voffA[2], voffB[2]; int gR[2], gRb[2]; unsigned gC2[2];
#pragma unroll
    for (int i = 0; i < 2; ++i) { int R, C; stage_rc(tid * 16 + i * 8192, R, C); const int Rb = Epi::PERM ? ((R & ~31) + perm32(R & 31)) : R;
        voffA[i] = (unsigned)(R * K + C) * 2u; voffB[i] = (unsigned)(Rb * K + C) * 2u; gR[i] = R; gC2[i] = (unsigned)C * 2u; gRb[i] = Rb; }
    const size_t kstep = (size_t)(BK * 2);
    const size_t hstep = (size_t)HALF * K * 2;
    const size_t tstep = 2 * hstep;
    const unsigned ldsw = (unsigned)wid * 1024u;
    const unsigned ldsb = (unsigned)(size_t)lds + ldsw;
    const int aoff = lds_byte(wr * 64 + fr, fq * 8), boff = lds_byte(wc * 32 + fr, fq * 8);
#define PG8_SA(b, h) (((b) * 2 + (h)) * HTB)
#define PG8_SB(b, h) ((4 + (b) * 2 + (h)) * HTB)
#define PG8_STAGE(bufoff, gbase, voff) do { _Pragma("unroll") for (int _i = 0; _i < 2; ++_i) PG8_GLDS_S(gbase, (voff)[_i], ldsb + (unsigned)((bufoff) + _i * 8192)); } while (0)
#define PG8_GLDS_S(sbase, voff32, ldsaddr) do { unsigned keep_; asm volatile("s_mov_b32 %0, m0\n\ts_mov_b32 m0, %3\n\ts_nop 0\n\tglobal_load_lds_dwordx4 %1, %2\n\ts_mov_b32 m0, %0" : "=&s"(keep_) : "v"(voff32), "s"((const char*)(sbase)), "s"(ldsaddr) : "memory"); } while (0)
#define PG8_GLDS_S1(sbase, voff32, ldsaddr) do { unsigned keep_; asm volatile("s_mov_b32 %0, m0\n\ts_mov_b32 m0, %3\n\ts_nop 0\n\tglobal_load_lds_dwordx4 %1, %2 sc1\n\ts_mov_b32 m0, %0" : "=&s"(keep_) : "v"(voff32), "s"((const char*)(sbase)), "s"(ldsaddr) : "memory"); } while (0)
#define PG8_KSEL_vc0 kc1
#define PG8_KSEL_w0 kw1
#define PG8_STAGE_A(bufoff, ptr, h, vsel0, vsel1) do { if constexpr (FP8) { if (PG8_KSEL_##vsel0) { _Pragma("unroll") for (int _i = 0; _i < 2; ++_i) PG8_GLDS_S1(ptr, ((h) == 0 ? vc0[_i] : vc1[_i]), ldsb + (unsigned)((bufoff) + _i * 8192)); } \
        else { _Pragma("unroll") for (int _i = 0; _i < 2; ++_i) PG8_GLDS_S(ptr, ((h) == 0 ? vc0[_i] : vc1[_i]), ldsb + (unsigned)((bufoff) + _i * 8192)); } } else if constexpr (GATHER) { if ((h) == 0) PG8_STAGE(bufoff, ptr, vsel0); else PG8_STAGE(bufoff, ptr, vsel1); } else { PG8_STAGE(bufoff, (ptr) + (h) * hstep, voffA); } } while (0)
#define PG8_STAGE_B(bufoff, ptr, h, NEXT) do { if constexpr (FP8) { const unsigned p_ = (NEXT) ? pw : pc; const unsigned vo_ = (unsigned)gRb[0] * p_ + gC2[0];   \
        _Pragma("unroll") for (int _i = 0; _i < 2; ++_i) PG8_GLDS_S((ptr) + (size_t)(((h) * 2 + _i) * 64) * p_, vo_, ldsb + (unsigned)((bufoff) + _i * 8192)); } else if constexpr (HET) { if (NEXT) PG8_STAGE(bufoff, (ptr) + (h) * hsw, wb); else PG8_STAGE(bufoff, (ptr) + (h) * hs, vb); } else { PG8_STAGE(bufoff, (ptr) + (h) * hstep, voffB); } } while (0)
#define PG8_LDA(dst, b, h) do { _Pragma("unroll") for (int m = 0; m < 4; ++m) _Pragma("unroll") for (int k = 0; k < 2; ++k) dst[m][k] = *(const PG8_LAS bf16x8*)(lds + PG8_SA(b, h) + aoff + m * 2048 + k * 1024); } while (0)
#define PG8_LDB(dst, b, h) do { _Pragma("unroll") for (int n = 0; n < 2; ++n) _Pragma("unroll") for (int k = 0; k < 2; ++k) dst[n][k] = *(const PG8_LAS bf16x8*)(lds + PG8_SB(b, h) + boff + n * 2048 + k * 1024); } while (0)
#define PG8_MMA(ai, bj, At, Bt) do { __builtin_amdgcn_s_setprio(1); _Pragma("unroll") for (int m = 0; m < 4; ++m) _Pragma("unroll") for (int n = 0; n < 2; ++n) { \
        if constexpr (FP8) { typedef int v8i_ __attribute__((ext_vector_type(8))); typedef int v4i_ __attribute__((ext_vector_type(4))); \
            const v4i_ b0_ = __builtin_bit_cast(v4i_, Bt[n][0]), b1_ = __builtin_bit_cast(v4i_, Bt[n][1]), a0_ = __builtin_bit_cast(v4i_, At[m][0]), a1_ = __builtin_bit_cast(v4i_, At[m][1]); \
            const v8i_ bb_ = {b0_[0], b0_[1], b0_[2], b0_[3], b1_[0], b1_[1], b1_[2], b1_[3]}, aa_ = {a0_[0], a0_[1], a0_[2], a0_[3], a1_[0], a1_[1], a1_[2], a1_[3]}; \
            acc[ai][bj][m][n] = __builtin_amdgcn_mfma_scale_f32_16x16x128_f8f6f4(bb_, aa_, acc[ai][bj][m][n], 0, 0, 0, 0, 0, 0); } \
        else { _Pragma("unroll") for (int k = 0; k < 2; ++k) acc[ai][bj][m][n] = __builtin_amdgcn_mfma_f32_16x16x32_bf16(Bt[n][k], At[m][k], acc[ai][bj][m][n], 0, 0, 0); } } \
        __builtin_amdgcn_s_setprio(0); } while (0)
#define PG8_WAIT_V(n) asm volatile("s_waitcnt vmcnt(" #n ")" ::: "memory")
#define PG8_WAIT_L(n) asm volatile("s_waitcnt lgkmcnt(" #n ")" ::: "memory")
#define PG8_BAR __builtin_amdgcn_s_barrier()
#define PG8_SCHED __builtin_amdgcn_sched_barrier(0)
    Unit cur, nxt; int ui = 0;
    if (!S.next(0, cur)) return;
    f32x4 acc[2][2][4][2];
#pragma unroll
    for (int a = 0; a < 2; ++a)
#pragma unroll
        for (int b = 0; b < 2; ++b)
#pragma unroll
            for (int m = 0; m < 4; ++m)
#pragma unroll
                for (int n = 0; n < 2; ++n) acc[a][b][m][n] = (f32x4){0.f, 0.f, 0.f, 0.f};
    bf16x8 At[4][2], B0[2][2], B1[2][2];
    unsigned vb[2] = {voffB[0], voffB[1]}, vbn[2] = {voffB[0], voffB[1]}, wb[2] = {voffB[0], voffB[1]}; size_t hs = hstep, hsn = hstep, hsw = hstep; int ntc = nt;
    auto kK = [&](int kind) { return kind ? g.K1 : g.K; };
    static_assert(!FP8 || (SP2 && GATHER && HET), "the FP8 form is written for the gathered heterogeneous stream");
    unsigned pc = (unsigned)g.K * 2u, pn = pc, pw = pc;
    bool kc1 = false, kw1 = false; (void)kc1; (void)kw1;
    if constexpr (FP8) { pc = (unsigned)kK(cur.kind) * 2u; pn = pc; pw = pc; hs = (size_t)HALF * pc; hsn = hs; ntc = kK(cur.kind) / BK; kc1 = cur.kind == 1; kw1 = kc1; }
    if constexpr (HET && !FP8) {
#pragma unroll
        for (int i = 0; i < 2; ++i) { vb[i] = (unsigned)(gRb[i] * kK(cur.kind)) * 2u + gC2[i]; vbn[i] = vb[i]; }
        hs = (size_t)HALF * kK(cur.kind) * 2; hsn = hs; ntc = kK(cur.kind) / BK; }
    const char* cA = HET ? (const char*)(cur.kind ? g.A1 : g.A) : (const char*)g.A + (GATHER ? (size_t)0 : (size_t)cur.pm * tstep);
    const char* cB = HET ? (const char*)(cur.kind ? g.Bt1 : g.Bt) + (size_t)cur.pn * (2 * hs) : (const char*)g.Bt + (size_t)cur.pn * tstep;
    unsigned vc0[2] = {0u, 0u}, vc1[2] = {0u, 0u}, vn0[2] = {0u, 0u}, vn1[2] = {0u, 0u};
    if constexpr (GATHER) {
#pragma unroll
        for (int i = 0; i < 2; ++i) { vc0[i] = rowtab[gR[i]] + gC2[i]; vc1[i] = rowtab[HALF + gR[i]] + gC2[i]; vn0[i] = vc0[i]; vn1[i] = vc1[i]; } }
    S.a_ready(cur);
    if constexpr (SP2) {
        PG8_STAGE_B(PG8_SB(0, 0), cB, 0, false); PG8_STAGE_B(PG8_SB(0, 1), cB, 1, false); PG8_STAGE_A(PG8_SA(0, 0), cA, 0, vc0, vc1); PG8_STAGE_A(PG8_SA(0, 1), cA, 1, vc0, vc1);
        if (wr == 1) PG8_BAR;
        PG8_WAIT_V(2); PG8_BAR;
        PG8_STAGE_B(PG8_SB(1, 0), cB + kstep, 0, false); PG8_STAGE_A(PG8_SA(1, 0), cA + kstep, 0, vc0, vc1); PG8_STAGE_B(PG8_SB(1, 1), cB + kstep, 1, false);
        PG8_WAIT_V(6); PG8_BAR;
    } else {
        PG8_STAGE_B(PG8_SB(0, 0), cB, 0, false); PG8_STAGE_A(PG8_SA(0, 0), cA, 0, vc0, vc1); PG8_STAGE_B(PG8_SB(0, 1), cB, 1, false); PG8_STAGE_A(PG8_SA(0, 1), cA, 1, vc0, vc1);
        if (wr == 1) PG8_BAR;
        PG8_WAIT_V(4); PG8_BAR;
        PG8_STAGE_B(PG8_SB(1, 0), cB + kstep, 0, false); PG8_STAGE_A(PG8_SA(1, 0), cA + kstep, 0, vc0, vc1); PG8_STAGE_B(PG8_SB(1, 1), cB + kstep, 1, false);
        PG8_WAIT_V(6); PG8_BAR;
    }
    for (;;) {
        const bool has_next = S.next(ui + 1, nxt);
        if constexpr (FP8) { pn = has_next ? (unsigned)kK(nxt.kind) * 2u : pc; hsn = (size_t)HALF * pn; }
        if constexpr (HET && !FP8) { if (has_next) {
#pragma unroll
                for (int i = 0; i < 2; ++i) vbn[i] = (unsigned)(gRb[i] * kK(nxt.kind)) * 2u + gC2[i];
                hsn = (size_t)HALF * kK(nxt.kind) * 2; } else { vbn[0] = vb[0]; vbn[1] = vb[1]; hsn = hs; } }
        const char* nA = HET ? (has_next ? (const char*)(nxt.kind ? g.A1 : g.A) : cA) : ((has_next && !GATHER) ? (const char*)g.A + (size_t)nxt.pm * tstep : cA);
        const char* nB = HET ? (has_next ? (const char*)(nxt.kind ? g.Bt1 : g.Bt) + (size_t)nxt.pn * (2 * hsn) : cB) : (has_next ? (const char*)g.Bt + (size_t)nxt.pn * tstep : cB);
        for (int t = 0; t < ntc; t += 2) {
            const bool last = (t == ntc - 2);
            const char* a1 = cA + (size_t)(t + 1) * kstep;
            const char* a2 = last ? nA : cA + (size_t)(t + 2) * kstep; const char* b2 = last ? nB : cB + (size_t)(t + 2) * kstep;
            const char* a3 = a2 + kstep; const char* b3 = b2 + kstep;
            if (last && has_next) S.a_ready(nxt);
            unsigned w0[2] = {0u, 0u}, w1[2] = {0u, 0u};
            if constexpr (FP8) { pw = last ? pn : pc; kw1 = (last && has_next) ? (nxt.kind == 1) : kc1;
                if (last && has_next) {
#pragma unroll
                    for (int i = 0; i < 2; ++i) vc0[i] = rowtab[(ui + 1) * BM + gR[0] + 64 * i] + gC2[0]; } }
            if constexpr (HET && !FP8) { wb[0] = last ? vbn[0] : vb[0]; wb[1] = last ? vbn[1] : vb[1]; hsw = last ? hsn : hs; }
            if constexpr (GATHER && !FP8) {
                if (last && has_next) {
#pragma unroll
                    for (int i = 0; i < 2; ++i) { vn0[i] = rowtab[(ui + 1) * BM + gR[i]] + gC2[i]; vn1[i] = rowtab[(ui + 1) * BM + HALF + gR[i]] + gC2[i]; } }
#pragma unroll
                for (int i = 0; i < 2; ++i) { w0[i] = last ? vn0[i] : vc0[i]; w1[i] = last ? vn1[i] : vc1[i]; } }
            if constexpr (SP2) {
            PG8_LDB(B0, 0, 0); PG8_LDB(B1, 0, 1); PG8_SCHED; PG8_LDA(At, 0, 0); PG8_STAGE_A(PG8_SA(1, 1), a1, 1, vc0, vc1);
            if constexpr (FP8) { if (last && has_next) {
#pragma unroll
                    for (int i = 0; i < 2; ++i) vc1[i] = rowtab[(ui + 1) * BM + HALF + gR[0] + 64 * i] + gC2[0]; } }
            PG8_WAIT_V(8); PG8_WAIT_L(0); PG8_BAR; PG8_MMA(0, 0, At, B0); PG8_MMA(0, 1, At, B1); PG8_BAR; PG8_SCHED;
            PG8_LDA(At, 0, 1); PG8_STAGE_B(PG8_SB(0, 0), b2, 0, true); PG8_STAGE_B(PG8_SB(0, 1), b2, 1, true); PG8_STAGE_A(PG8_SA(0, 0), a2, 0, w0, w1);
            PG8_WAIT_V(8); PG8_WAIT_L(0); PG8_BAR; PG8_MMA(1, 0, At, B0); PG8_MMA(1, 1, At, B1); PG8_BAR; PG8_SCHED;
            PG8_LDB(B0, 1, 0); PG8_LDB(B1, 1, 1); PG8_SCHED; PG8_LDA(At, 1, 0); PG8_STAGE_A(PG8_SA(0, 1), a2, 1, w0, w1);
            PG8_WAIT_V(8); PG8_WAIT_L(0); PG8_BAR; PG8_MMA(0, 0, At, B0); PG8_MMA(0, 1, At, B1); PG8_BAR; PG8_SCHED;
            PG8_LDA(At, 1, 1); PG8_STAGE_B(PG8_SB(1, 0), b3, 0, true); PG8_STAGE_B(PG8_SB(1, 1), b3, 1, true); PG8_STAGE_A(PG8_SA(1, 0), a3, 0, w0, w1);
            PG8_WAIT_V(8); PG8_WAIT_L(0); PG8_BAR; PG8_MMA(1, 0, At, B0); PG8_MMA(1, 1, At, B1); PG8_BAR; PG8_SCHED;
            } else {
            PG8_LDB(B0, 0, 0); PG8_SCHED; PG8_LDA(At, 0, 0); PG8_STAGE_A(PG8_SA(1, 1), a1, 1, vc0, vc1);
            PG8_WAIT_L(8); PG8_BAR; PG8_WAIT_L(0); PG8_MMA(0, 0, At, B0); PG8_BAR; PG8_SCHED;
            PG8_LDB(B1, 0, 1); PG8_STAGE_B(PG8_SB(0, 0), b2, 0, true);
            PG8_BAR; PG8_WAIT_L(0); PG8_MMA(0, 1, At, B1); PG8_BAR;
            PG8_LDA(At, 0, 1); PG8_STAGE_A(PG8_SA(0, 0), a2, 0, w0, w1);
            PG8_BAR; PG8_WAIT_L(0); PG8_MMA(1, 0, At, B0); PG8_BAR; PG8_SCHED;
            PG8_STAGE_B(PG8_SB(0, 1), b2, 1, true);
            PG8_WAIT_V(6); PG8_BAR; PG8_MMA(1, 1, At, B1); PG8_BAR;
            PG8_LDB(B0, 1, 0); PG8_SCHED; PG8_LDA(At, 1, 0); PG8_STAGE_A(PG8_SA(0, 1), a2, 1, w0, w1);
            PG8_WAIT_L(8); PG8_BAR; PG8_WAIT_L(0); PG8_MMA(0, 0, At, B0); PG8_BAR; PG8_SCHED;
            PG8_LDB(B1, 1, 1); PG8_STAGE_B(PG8_SB(1, 0), b3, 0, true);
            PG8_BAR; PG8_WAIT_L(0); PG8_MMA(0, 1, At, B1); PG8_BAR;
            PG8_LDA(At, 1, 1); PG8_STAGE_A(PG8_SA(1, 0), a3, 0, w0, w1);
            PG8_BAR; PG8_WAIT_L(0); PG8_MMA(1, 0, At, B0); PG8_BAR; PG8_SCHED;
            PG8_STAGE_B(PG8_SB(1, 1), b3, 1, true);
            PG8_WAIT_V(6); PG8_BAR; PG8_MMA(1, 1, At, B1); PG8_BAR;
            }
        }
        if constexpr (ALIGN_EPI) { if (wr == 0) PG8_BAR; }
        if constexpr (!Epi::AFTER_DRAIN) { E(acc, cur, wr, wc, fr, fq); S.done(cur); }
        if (!has_next) break;
#pragma unroll
        for (int a = 0; a < 2; ++a)
#pragma unroll
            for (int b = 0; b < 2; ++b)
#pragma unroll
                for (int m = 0; m < 4; ++m)
#pragma unroll
                    for (int n = 0; n < 2; ++n) acc[a][b][m][n] = (f32x4){0.f, 0.f, 0.f, 0.f};
        cur = nxt; cA = nA; cB = nB; ++ui;
        if constexpr (FP8) { pc = pn; hs = hsn; ntc = kK(cur.kind) / BK; kc1 = cur.kind == 1; }
        if constexpr (HET && !FP8) { vb[0] = vbn[0]; vb[1] = vbn[1]; hs = hsn; ntc = kK(cur.kind) / BK; }
        if constexpr (GATHER && !FP8) {
#pragma unroll
            for (int i = 0; i < 2; ++i) { vc0[i] = vn0[i]; vc1[i] = vn1[i]; } }
        if constexpr (ALIGN_EPI) { if (wr == 1) PG8_BAR; }
    }
    PG8_WAIT_V(0);
    if constexpr (!ALIGN_EPI) { if (wr == 0) PG8_BAR; }
    PG8_BAR;
    if constexpr (Epi::AFTER_DRAIN) { E.fused(acc, cur, wr, wc, fr, fq, lds, wid, lane); S.done(cur); }
#undef PG8_SA
#undef PG8_SB
#undef PG8_STAGE
#undef PG8_STAGE_A
#undef PG8_STAGE_B
#undef PG8_LDA
#undef PG8_LDB
#undef PG8_MMA
#undef PG8_WAIT_V
#undef PG8_WAIT_L
#undef PG8_BAR
#undef PG8_SCHED
}
}

namespace attn {
using bf16 = unsigned short;
constexpr int   D = 128, NW = 8, QBLK = 32, KVBLK = 64;
constexpr float POFF = 2.f;
constexpr float SCALE = 0.088388347648318440f;
constexpr float THR = 8.f;
constexpr int SDEPTH = 2;
constexpr int LDQ = 1024, LDK = 256, LDO = 1024;
constexpr size_t SHM_V = KVBLK * D * 2, SHM_K = KVBLK * D * 2, SHM_ATTN = 2 * SHM_V + 2 * SHM_K + NW * 64 * 4;
using bf16x8 = __attribute__((ext_vector_type(8))) short;
using s16x4  = __attribute__((ext_vector_type(4))) short;
using f32x16 = __attribute__((ext_vector_type(16))) float;
using f32x8  = __attribute__((ext_vector_type(8))) float;
using u32x4  = __attribute__((ext_vector_type(4))) unsigned;
#define KSWZ(row, colB) ((row) * 256 + ((colB) ^ (((row) & 7) << 4)))
#define SBAR() __builtin_amdgcn_sched_barrier(0)
__device__ __forceinline__ int crow(int r, int hi) { return (r & 3) + 8 * (r >> 2) + 4 * hi; }
__device__ __forceinline__ unsigned cvtpk(float lo, float hi) {
  unsigned r; asm volatile("v_cvt_pk_bf16_f32 %0, %1, %2" : "=v"(r) : "v"(lo), "v"(hi)); return r;
}
template <typename TIn> struct Stage;
template <> struct Stage<bf16>  { using T = bf16x8;
  __device__ static __forceinline__ T ld8(const bf16* p) { return *reinterpret_cast<const bf16x8*>(p); }
  __device__ static __forceinline__ T ld8s(const char* sbase, unsigned off) { T r; asm volatile("global_load_dwordx4 %0, %1, %2" : "=v"(r) : "v"(off), "s"(sbase) : "memory"); return r; }
  __device__ static __forceinline__ bf16x8 tobf(T x) { return x; } };
__device__ __forceinline__ unsigned short f2bf_(float f) { unsigned u = __builtin_bit_cast(unsigned, f); return (unsigned short)((u + 0x7fffu + ((u >> 16) & 1u)) >> 16); }

__device__ __forceinline__ void partialSM(f32x16& p0, f32x16& p1, float& m_reg, float& mn, float& alpha) {
  constexpr float C = 1.f;
  float pmax = p0[0]; for (int r = 1; r < 16; ++r) pmax = fmaxf(pmax, p0[r]); for (int r = 0; r < 16; ++r) pmax = fmaxf(pmax, p1[r]);
  { auto rr = __builtin_amdgcn_permlane32_swap(__float_as_uint(pmax), __float_as_uint(pmax), false, false);
    pmax = fmaxf(__uint_as_float(rr[0]), __uint_as_float(rr[1])); }
  if (__builtin_expect(__all(pmax - m_reg <= THR * 1.4426950408889634f), 1)) { mn = m_reg; alpha = 1.f; }
  else { mn = fmaxf(m_reg, pmax); alpha = __builtin_amdgcn_exp2f((m_reg - mn) * C); m_reg = mn; }
  float mnC = -mn * C;
  for (int r = 0; r < 16; ++r) p0[r] = fmaf(p0[r], C, mnC); for (int r = 0; r < 16; ++r) p1[r] = fmaf(p1[r], C, mnC);
  for (int r = 0; r < 16; ++r) p0[r] = __builtin_amdgcn_exp2f(p0[r]);
}
typedef int v8i_ __attribute__((ext_vector_type(8)));
__device__ __forceinline__ void finishSM(f32x16& p0, f32x16& p1, float alpha, float& l_reg, v8i_& pa) {
  for (int r = 0; r < 16; ++r) p1[r] = __builtin_amdgcn_exp2f(p1[r]);
  (void)alpha; (void)l_reg;
#define PK8(G) do { int x_ = 0, y_ = 0; x_ = __builtin_amdgcn_cvt_pk_fp8_f32(p0[4 * G], p0[4 * G + 1], x_, false); x_ = __builtin_amdgcn_cvt_pk_fp8_f32(p0[4 * G + 2], p0[4 * G + 3], x_, true); \
    y_ = __builtin_amdgcn_cvt_pk_fp8_f32(p1[4 * G], p1[4 * G + 1], y_, false); y_ = __builtin_amdgcn_cvt_pk_fp8_f32(p1[4 * G + 2], p1[4 * G + 3], y_, true); \
    auto r_ = __builtin_amdgcn_permlane32_swap((unsigned)x_, (unsigned)y_, false, false); pa[2 * G] = (int)r_[0]; pa[2 * G + 1] = (int)r_[1]; } while (0)
  PK8(0); PK8(1); PK8(2); PK8(3);
#undef PK8
}
#define KSWZ8(row, ch) ((row) * 128 + (((((ch) + ((row) >> 3)) & 7) ^ ((row) & 7)) << 4))
__device__ __forceinline__ void qkt(f32x16& p0, f32x16& p1, const bf16* Ks, const v8i_* q8, int r32, int hi) {
  typedef int v4i_ __attribute__((ext_vector_type(4)));
  for (int r = 0; r < 16; ++r) { p0[r] = -POFF; p1[r] = -POFF; }
  for (int ks = 0; ks < 2; ++ks) { const int ch = ks * 4 + hi * 2;
    const v4i_ a0 = *reinterpret_cast<const v4i_*>((const char*)Ks + KSWZ8(r32, ch)), a1 = *reinterpret_cast<const v4i_*>((const char*)Ks + KSWZ8(r32, ch + 1));
    const v4i_ b0 = *reinterpret_cast<const v4i_*>((const char*)Ks + KSWZ8(32 + r32, ch)), b1 = *reinterpret_cast<const v4i_*>((const char*)Ks + KSWZ8(32 + r32, ch + 1));
    const v8i_ ka = {a0[0], a0[1], a0[2], a0[3], a1[0], a1[1], a1[2], a1[3]}, kb = {b0[0], b0[1], b0[2], b0[3], b1[0], b1[1], b1[2], b1[3]};
    p0 = __builtin_amdgcn_mfma_scale_f32_32x32x64_f8f6f4(ka, q8[ks], p0, 0, 0, 0, 0, 0, 0);
    p1 = __builtin_amdgcn_mfma_scale_f32_32x32x64_f8f6f4(kb, q8[ks], p1, 0, 0, 0, 0, 0, 0); }
}
__device__ __forceinline__ int v_st(int k, int c) { const int kk = (k & ~0xC) | ((k & 4) << 1) | ((k & 8) >> 1); return ((kk >> 3) * 4 + (c >> 5)) * 512 + ((kk & 7) * 32 + (c & 31)) * 2; }
__device__ __forceinline__ int v_rd_base(int lane) { return ((lane & 3) << 3) | (((lane >> 2) & 3) << 6) | (((lane >> 4) & 1) << 5) | (((lane >> 5) & 1) << 8); }
constexpr int v_rd_off(int d0, int ks, int half) { return d0 * 512 + ks * 4096 + half * 2048; }
template <int OFF> __device__ __forceinline__ s16x4 tr_read(int vb) {
  s16x4 r; asm volatile("ds_read_b64_tr_b16 %0, %1 offset:%2" : "=&v"(r) : "v"(vb), "i"(OFF) : "memory"); return r;
}
template <int D0> __device__ __forceinline__ void pv_one(f32x16& od, int vb, bf16x8 pa0, bf16x8 pa1, bf16x8 pa2, bf16x8 pa3) {
  const s16x4 l0 = tr_read<v_rd_off(D0, 0, 0)>(vb), h0 = tr_read<v_rd_off(D0, 0, 1)>(vb), l1 = tr_read<v_rd_off(D0, 1, 0)>(vb), h1 = tr_read<v_rd_off(D0, 1, 1)>(vb);
  const s16x4 l2 = tr_read<v_rd_off(D0, 2, 0)>(vb), h2 = tr_read<v_rd_off(D0, 2, 1)>(vb), l3 = tr_read<v_rd_off(D0, 3, 0)>(vb), h3 = tr_read<v_rd_off(D0, 3, 1)>(vb);
  asm volatile("s_waitcnt lgkmcnt(0)" ::: "memory"); SBAR();
#define PK(L, H) (bf16x8){L[0], L[1], L[2], L[3], H[0], H[1], H[2], H[3]}
  od = __builtin_amdgcn_mfma_f32_32x32x16_bf16(pa0, PK(l0, h0), od, 0, 0, 0);
  od = __builtin_amdgcn_mfma_f32_32x32x16_bf16(pa1, PK(l1, h1), od, 0, 0, 0);
  od = __builtin_amdgcn_mfma_f32_32x32x16_bf16(pa2, PK(l2, h2), od, 0, 0, 0);
  od = __builtin_amdgcn_mfma_f32_32x32x16_bf16(pa3, PK(l3, h3), od, 0, 0, 0);
#undef PK
}
#define VSWZ8(d, c) ((d) * 64 + ((((c) ^ ((d) >> 2)) & 3) << 4))
__device__ __forceinline__ void pv_d0(f32x16* o, const char* Vs, v8i_ pa, int r32, int hi) {
  typedef int v4i_ __attribute__((ext_vector_type(4)));
#pragma unroll
  for (int db = 0; db < 4; ++db) { const int d = db * 32 + r32;
    const v4i_ x0 = *reinterpret_cast<const v4i_*>(Vs + VSWZ8(d, 2 * hi)), x1 = *reinterpret_cast<const v4i_*>(Vs + VSWZ8(d, 2 * hi + 1));
    const v8i_ vb = {x0[0], x0[1], x0[2], x0[3], x1[0], x1[1], x1[2], x1[3]};
    o[db] = __builtin_amdgcn_mfma_scale_f32_32x32x64_f8f6f4(pa, vb, o[db], 0, 0, 0, 0, 0, 0); }
  const v8i_ ones = {0x38383838, 0x38383838, 0x38383838, 0x38383838, 0x38383838, 0x38383838, 0x38383838, 0x38383838};
  o[4] = __builtin_amdgcn_mfma_scale_f32_32x32x64_f8f6f4(pa, ones, o[4], 0, 0, 0, 0, 0, 0);
}

template <bool FAST, class Hook>
__device__ __forceinline__ void attn_dense_body(const bf16* __restrict__ Qb, const bf16* __restrict__ Kh, const bf16* __restrict__ Vh,
                                                bf16* __restrict__ Ob, int seq, char* lds, Hook& hk, int wave_) {
  using St = Stage<bf16>; using SQ = Stage<bf16>; typedef bf16 TQ;
  int lane; asm volatile("v_mbcnt_lo_u32_b32 %0, -1, 0\n\tv_mbcnt_hi_u32_b32 %0, -1, %0" : "=v"(lane));
  const int wid = wave_, tid = wid * 64 + lane, r32 = lane & 31, hi = lane >> 5;
  bf16* V_lds = (bf16*)lds; bf16* K_lds = (bf16*)(lds + 2 * SHM_V);
  float* ws = (float*)(lds + 2 * SHM_V + 2 * SHM_K) + wid * 64; float* li_l = ws; float* al_l = ws + 32;
  float m_reg = -1e30f, l_reg = 0; f32x16 o[5] = {}; v8i_ qr[2];
  { typedef int v4i_ __attribute__((ext_vector_type(4)));
    const char* Qw = (const char*)Qb + (long)(wid * QBLK + r32) * LDQ + hi * 32;
#pragma unroll
    for (int ks = 0; ks < 2; ++ks) { const v4i_ x0 = *reinterpret_cast<const v4i_*>(Qw + ks * 64), x1 = *reinterpret_cast<const v4i_*>(Qw + ks * 64 + 16);
      qr[ks] = (v8i_){x0[0], x0[1], x0[2], x0[3], x1[0], x1[1], x1[2], x1[3]}; } }
  const int sr = tid >> 4, sc = (tid & 15) * 8, vst0 = v_st(sr, sc), vst1 = v_st(32 + sr, sc);
  const char* vb0 = (const char*)V_lds;
  struct { typename St::T vs0, vs1, ks0, ks1; } sr_[SDEPTH];
  const unsigned slo = (unsigned)(sr * LDK + sc) * 2u;
  const unsigned slok = (unsigned)((tid >> 3) * LDK + (tid & 7) * 16);
  const unsigned slov = (unsigned)((tid >> 2) * seq + (tid & 3) * 16);
#define SLOAD(i, k0) do { const char* vb_ = (const char*)Vh + (k0); const char* kb_ = (const char*)Kh + (long)(k0) * LDK; \
    sr_[i].vs0 = St::ld8s(vb_, slov); \
    sr_[i].ks0 = St::ld8s(kb_, slok); } while (0)
#define SWRITE(b, i) do { *(bf16x8*)((char*)V_lds + (b) * SHM_V + VSWZ8(tid >> 2, tid & 3)) = St::tobf(sr_[i].vs0); int kc = sc * 2;          \
    *(bf16x8*)((char*)K_lds + (b) * SHM_K + KSWZ8(tid >> 3, tid & 7)) = St::tobf(sr_[i].ks0); (void)kc; } while (0)
#define SWAIT() do { if constexpr (SDEPTH == 2) asm volatile("s_waitcnt vmcnt(2)" ::: "memory");     else asm volatile("s_waitcnt vmcnt(0)" ::: "memory"); } while (0)
#define RESC(a) do { if (__any((a) < 1.f)) { if (hi == 0) al_l[r32] = (a); asm volatile("s_waitcnt lgkmcnt(0)" ::: "memory"); \
    for (int d = 0; d < 5; ++d) for (int r = 0; r < 16; ++r) o[d][r] *= al_l[crow(r, hi)]; } } while (0)
  f32x16 pA0, pA1, pB0, pB1; float mnA = 0.f, mnB = 0.f, alA = 1.f, alB = 1.f; v8i_ pa8; const int NT = seq / KVBLK;
#define PSM(P0, P1, MN, AL) do { if constexpr (FAST) { _Pragma("unroll") for (int r_ = 0; r_ < 16; ++r_) P0[r_] = __builtin_amdgcn_exp2f(P0[r_]); } else partialSM(P0, P1, m_reg, MN, AL); } while (0)
#define RESCF(a) do { if constexpr (!FAST) RESC(a); } while (0)
  constexpr int SE = 0, SO = SDEPTH - 1;
  SLOAD(SE, 0); asm volatile("s_waitcnt vmcnt(0)" ::: "memory"); SWRITE(0, SE); __syncthreads();
  qkt(pA0, pA1, K_lds, qr, r32, hi); PSM(pA0, pA1, mnA, alA);
  SLOAD(SO, KVBLK); if constexpr (SDEPTH == 2) { if (2 < NT) SLOAD(SE, 2 * KVBLK); }
  SWAIT(); SWRITE(1, SO); __syncthreads();
  for (int j = 1; j + 1 < NT; j += 2) {
    SBAR(); qkt(pB0, pB1, (bf16*)((char*)K_lds + SHM_K), qr, r32, hi);
    finishSM(pA0, pA1, alA, l_reg, pa8); SBAR();
    SLOAD(SO, (j + SDEPTH) * KVBLK); SBAR();
    pv_d0(o, vb0, pa8, r32, hi); PSM(pB0, pB1, mnB, alB);
    __syncthreads(); SWAIT(); SWRITE(0, SE);
    RESCF(alB); hk.step(true); __syncthreads();
    SBAR(); qkt(pA0, pA1, K_lds, qr, r32, hi);
    finishSM(pB0, pB1, alB, l_reg, pa8); SBAR();
    if (SDEPTH == 1 || j + 3 < NT) SLOAD(SE, (j + 1 + SDEPTH) * KVBLK); SBAR();
    pv_d0(o, vb0 + SHM_V, pa8, r32, hi); PSM(pA0, pA1, mnA, alA);
    __syncthreads(); if (SDEPTH == 1 || j + 3 < NT) SWAIT(); else asm volatile("s_waitcnt vmcnt(0)" ::: "memory"); SWRITE(1, SO);
    RESCF(alA); hk.step(SDEPTH == 1 || j + 3 < NT); __syncthreads();
  }
  SBAR(); qkt(pB0, pB1, (bf16*)((char*)K_lds + SHM_K), qr, r32, hi);
  finishSM(pA0, pA1, alA, l_reg, pa8); SBAR();
  pv_d0(o, vb0, pa8, r32, hi); PSM(pB0, pB1, mnB, alB);
  __syncthreads(); RESCF(alB);
  finishSM(pB0, pB1, alB, l_reg, pa8); SBAR();
  pv_d0(o, vb0 + SHM_V, pa8, r32, hi);
  (void)li_l;
  float rli[16];
#pragma unroll
  for (int r = 0; r < 16; ++r) rli[r] = __builtin_amdgcn_rcpf(o[4][r]);
  unsigned char* Ow = (unsigned char*)Ob + (long)(wid * QBLK) * LDO;
#pragma unroll
  for (int r = 0; r < 16; ++r) { int orow = crow(r, hi); const float sc_ = rli[r] * 64.f;
    for (int d0 = 0; d0 < 4; ++d0) { const float ov_ = o[d0][r] * sc_; Ow[(long)orow * LDO + d0 * 32 + r32] = (unsigned char)__builtin_amdgcn_cvt_pk_fp8_f32(ov_, ov_, 0, false); } }
#undef SLOAD
#undef SWRITE
#undef SWAIT
#undef RESC
#undef RESCF
#undef PSM
}

#undef KSWZ
#undef SBAR
}

#define GAS __attribute__((address_space(1)))
#define LAS __attribute__((address_space(3)))
typedef unsigned short bf16;
typedef unsigned v4u __attribute__((ext_vector_type(4)));
typedef float f32x4 __attribute__((ext_vector_type(4)));
typedef short bf16x8 __attribute__((ext_vector_type(8)));
typedef GAS unsigned gu32;
typedef GAS unsigned long long gu64;
#define RLX_AGENT __ATOMIC_RELAXED, __HIP_MEMORY_SCOPE_AGENT
#define LDS_WAIT() asm volatile("s_waitcnt lgkmcnt(0)" ::: "memory")
#define VM_WAIT() asm volatile("s_waitcnt vmcnt(0)" ::: "memory")
__device__ __forceinline__ unsigned f2bf(float f) { unsigned u = __builtin_bit_cast(unsigned, f); return (u + 0x7fffu + ((u >> 16) & 1u)) >> 16; }
__device__ __forceinline__ unsigned pk2(float lo, float hi) { return f2bf(lo) | (f2bf(hi) << 16); }
__device__ __forceinline__ float bflo(unsigned w) { return __uint_as_float(w << 16); }
__device__ __forceinline__ float bfhi(unsigned w) { return __uint_as_float(w & 0xffff0000u); }

#define XB_TMO      128
#define XB_XCNT(j)  (256  + 64 * (j))
#define XB_XSUB(j)  (1280 + 64 * (j))
#define XB_XGEN(j)  (2304 + 64 * (j))
#define XB_TOP      3328
#define XB_TOPGEN   3392
#define XCD_BAR_WORDS 3456
#define XB_SPIN_CAP (1u << 18)

__device__ __forceinline__ unsigned xb_ld(unsigned* p)              { return __hip_atomic_load(p, __ATOMIC_RELAXED, __HIP_MEMORY_SCOPE_AGENT); }
__device__ __forceinline__ unsigned xb_add(unsigned* p, unsigned v) { return __hip_atomic_fetch_add(p, v, __ATOMIC_RELAXED, __HIP_MEMORY_SCOPE_AGENT); }
__device__ __forceinline__ unsigned xb_xcc_id() { return (unsigned)__builtin_amdgcn_s_getreg((3 << 11) | 20) & 0xFu; }
#define XB_SPIN(cond, bar) do { unsigned _sp = 0; while (cond) { __builtin_amdgcn_s_sleep(1); \
    if ((++_sp & 255u) == 0u) { if (xb_ld(&(bar)[XB_TMO])) break; if (_sp > XB_SPIN_CAP) { atomicAdd(&(bar)[XB_TMO], 1u); break; } } } } while (0)

__device__ __forceinline__ bool xb_thread0(int wave) { int l; asm volatile("v_mbcnt_lo_u32_b32 %0, -1, 0\n\tv_mbcnt_hi_u32_b32 %0, -1, %0" : "=v"(l)); return wave == 0 && l == 0; }
struct XcdBarrier {
    int wave;
    unsigned* bar; unsigned x;
    volatile LAS unsigned* st;
};

__device__ __forceinline__ XcdBarrier xcd_barrier_post(unsigned* bar, volatile LAS unsigned* st, int wave) {
    XcdBarrier b; b.wave = wave; b.bar = bar; b.x = xb_xcc_id(); b.st = st;
    if (xb_thread0(wave)) (void)xb_add(&bar[XB_XCNT(b.x)], 1u);
    return b;
}
__device__ __forceinline__ void xcd_barrier_complete(unsigned* bar, unsigned x, unsigned& nloc, unsigned& nx) {
    const unsigned G = gridDim.x * gridDim.y * gridDim.z;
    unsigned sum, cnt, mine, sp = 0u;
    for (;;) {
        sum = 0u; cnt = 0u; mine = 0u;
#pragma unroll
        for (unsigned j = 0; j < 16; ++j) { const unsigned c = xb_ld(&bar[XB_XCNT(j)]); sum += c; cnt += (c > 0u) ? 1u : 0u; mine = (j == x) ? c : mine; }
        if (sum == G) break;
        __builtin_amdgcn_s_sleep(1);
        if ((++sp & 255u) == 0u) { if (xb_ld(&bar[XB_TMO])) break; if (sp > XB_SPIN_CAP) { atomicAdd(&bar[XB_TMO], 1u); break; } }
    }
    nloc = mine > 0u ? mine : 1u; nx = cnt > 0u ? cnt : 1u;
}

__device__ __forceinline__ void xcd_barrier(const XcdBarrier& b) {
    asm volatile("s_waitcnt vmcnt(0)" ::: "memory");
    __syncthreads();
    if (xb_thread0(b.wave)) {
        unsigned* bar = b.bar;
        __builtin_amdgcn_s_waitcnt(0);
        unsigned nloc = b.st[0], nx = b.st[1];
        if (nloc == 0u) { xcd_barrier_complete(bar, b.x, nloc, nx); b.st[0] = nloc; b.st[1] = nx; }
        const unsigned old = xb_add(&bar[XB_XSUB(b.x)], 1u);
        const unsigned gen = old / nloc;
        if (old + 1u == (gen + 1u) * nloc) {
            __builtin_amdgcn_fence(__ATOMIC_RELEASE, "agent");
            asm volatile("s_waitcnt vmcnt(0)" ::: "memory");
            const unsigned og = xb_add(&bar[XB_TOP], 1u);
            const unsigned tg = og / nx;
            if (og + 1u == (tg + 1u) * nx) xb_add(&bar[XB_TOPGEN], 1u);
            else XB_SPIN(xb_ld(&bar[XB_TOPGEN]) == tg, bar);
            __builtin_amdgcn_fence(__ATOMIC_ACQUIRE, "agent");
            xb_add(&bar[XB_XGEN(b.x)], 1u);
            asm volatile("s_waitcnt vmcnt(0)" ::: "memory");
        } else {
            XB_SPIN(xb_ld(&bar[XB_XGEN(b.x)]) == gen, bar);
            __builtin_amdgcn_fence(__ATOMIC_ACQUIRE, "agent");
            asm volatile("s_waitcnt vmcnt(0)" ::: "memory");
        }
    }
    __syncthreads();
}


struct Frame {
    LAS unsigned char* lds;
    volatile LAS unsigned* MISC;
    gu32* ctl;
    unsigned char* ws;
    int wave;
    int vcu, G;
    float* out;
};
__device__ __forceinline__ int lane_id() { int l; asm volatile("v_mbcnt_lo_u32_b32 %0, -1, 0\n\tv_mbcnt_hi_u32_b32 %0, -1, %0" : "=v"(l)); return l; }
struct TokRec { int e0, e1, pos0, pos1; float w0, w1; int s0, s1; };

__device__ __forceinline__ float wave_sum(float v) {
#pragma unroll
    for (int o = 1; o < 64; o <<= 1) v += __shfl_xor(v, o);
    return v;
}
__device__ __forceinline__ void transpose_item(const float* W, int ldw, int k0, int n0, bf16* dst, int ldd, LAS float* scr, int lane) {
    const int r8 = lane >> 3, c4 = (lane & 7) * 4;
    f32x4 v[8];
#pragma unroll
    for (int i = 0; i < 8; ++i) v[i] = *(const GAS f32x4*)(W + (size_t)(k0 + 8 * i + r8) * ldw + n0 + c4);
#pragma unroll
    for (int i = 0; i < 8; ++i) { LAS float* q = scr + (8 * i + r8) * 33 + c4; q[0] = v[i].x; q[1] = v[i].y; q[2] = v[i].z; q[3] = v[i].w; }
    LDS_WAIT(); asm volatile("" ::: "memory");
    const int c = lane & 7;
#pragma unroll
    for (int j = 0; j < 4; ++j) { const int n = (lane >> 3) + 8 * j; const LAS float* s = scr + (8 * c) * 33 + n;
        v4u o; o.x = pk2(s[0 * 33], s[1 * 33]); o.y = pk2(s[2 * 33], s[3 * 33]); o.z = pk2(s[4 * 33], s[5 * 33]); o.w = pk2(s[6 * 33], s[7 * 33]);
        *(GAS v4u*)(dst + (size_t)n * ldd + 8 * c) = o; }
    LDS_WAIT(); asm volatile("" ::: "memory");
}

__device__ __forceinline__ void transpose_item_fp8(const float* W, int ldw, int k0, int n0, unsigned char* dst, LAS float* scr, int lane) {
    const int r8 = lane >> 3, c4 = (lane & 7) * 4;
    f32x4 v[8];
#pragma unroll
    for (int i = 0; i < 8; ++i) v[i] = *(const GAS f32x4*)(W + (size_t)(k0 + 8 * i + r8) * ldw + n0 + c4);
#pragma unroll
    for (int i = 0; i < 8; ++i) { LAS float* q = scr + (8 * i + r8) * 33 + c4; q[0] = v[i].x; q[1] = v[i].y; q[2] = v[i].z; q[3] = v[i].w; }
    LDS_WAIT(); asm volatile("" ::: "memory");
    const int c = lane & 7;
#pragma unroll
    for (int j = 0; j < 4; ++j) { const int n = (lane >> 3) + 8 * j; const LAS float* s = scr + (8 * c) * 33 + n;
        const float f[8] = {s[0 * 33], s[1 * 33], s[2 * 33], s[3 * 33], s[4 * 33], s[5 * 33], s[6 * 33], s[7 * 33]};
        typedef unsigned v2u_ __attribute__((ext_vector_type(2))); unsigned o0, o1; cvt8_fp8_x32(f, o0, o1); const v2u_ o = {o0, o1};
        *(GAS v2u_*)(dst + (size_t)n * 1024 + 8 * c) = o; }
    LDS_WAIT(); asm volatile("" ::: "memory");
}

__device__ __forceinline__ void p0_prologue(Frame& F, const float* x, const float* g1, const float* w_in, const float* w_co, const float* w_ao, const float* w_o, const float* w_grp, const float* w_rt, int part, int gw_, int ngw_) {
    LAS float* scr = (LAS float*)(F.lds + F.wave * 16384);
    const int gw = part == 2 ? gw_ : F.vcu * 8 + F.wave, NGW = part == 2 ? ngw_ : F.G * 8, lane = lane_id(), tid = F.wave * 64 + lane;
    constexpr int I_IN = 16 * (DIN / 32);
    constexpr int I_SQ = 16 * 32;
    constexpr int NITEMS = I_IN + 3 * I_SQ;
    bf16* WinT = (bf16*)(F.ws + WS_WIN);
    for (int it = (part == 2 ? I_IN : 0) + gw; it < (part == 1 ? I_IN : NITEMS); it += NGW) {
        int r = it;
        if (r < I_IN) { const int nblk = DIN / 32, kb = r / nblk, nb = r % nblk, n0 = 32 * nb;
            int drow = n0; if (n0 >= 1024 && n0 < 3072) { const int sx = n0 >= 2048 ? 1 : 0, c0 = n0 - 1024 - 1024 * sx; drow = 1024 + 256 * (c0 >> 7) + 128 * sx + (c0 & 127); }
            if (n0 >= N8_0) transpose_item_fp8(w_in, DIN, 64 * kb, n0, F.ws + WS_W8 + (size_t)(n0 - N8_0) * 1024 + 64 * kb, scr, lane);
            else transpose_item(w_in, DIN, 64 * kb, n0, WinT + (size_t)drow * 1024 + 64 * kb, 1024, scr, lane);
            continue; } r -= I_IN;
        if (r < 3 * I_SQ) { const int which = r / I_SQ, q = r % I_SQ, kb = q / 32, nb = q % 32;
            const float* W = which == 0 ? w_co : which == 1 ? w_ao : w_o; bf16* D = (bf16*)(F.ws + (which == 0 ? WS_WC : which == 1 ? WS_WA : WS_WO));
            if (which == 1) transpose_item_fp8(W, 1024, 64 * kb, 32 * nb, F.ws + WS_WA + (size_t)(32 * nb) * 1024 + 64 * kb, scr, lane);
            else transpose_item(W, 1024, 64 * kb, 32 * nb, D + (size_t)(32 * nb) * 1024 + 64 * kb, 1024, scr, lane);
            continue; } r -= 3 * I_SQ;
    }
    if (part == 2) return;
    { bf16* hi = (bf16*)(F.ws + WS_WRT); bf16* lo = hi + NROUTE_PAD * 1024;
      for (int i = F.vcu * 512 + tid; i < NROUTE_PAD * 1024; i += F.G * 512) { const int n = i >> 10, k = i & 1023;
          const float v = n < 8 ? w_grp[k * 8 + n] : n < NROUTE ? w_rt[k * 64 + (n - 8)] : 0.f;
          const unsigned h = f2bf(v); const float r = v - __uint_as_float(h << 16); hi[i] = (bf16)h; lo[i] = (bf16)f2bf(r); } }
    { float* ct = (float*)(F.ws + WS_ROPE); float* st = ct + 2048;
      for (int i = F.vcu * 512 + tid; i < 2048; i += F.G * 512) { const int pos = i >> 5, j = i & 31;
          const float inv = exp2f(-(float)(2 * j) * (13.287712379549449f / 64.0f));
          const float ang = (float)pos * inv; ct[i] = cosf(ang); st[i] = sinf(ang); } }
    { bf16* U = (bf16*)(F.ws + WS_R1);
      const GAS f32x4* gr = (const GAS f32x4*)g1 + lane; f32x4 gq[4];
#pragma unroll
      for (int j = 0; j < 4; ++j) gq[j] = gr[64 * j];
      f32x4 v[4], w[4];
      if (gw < T) {
#pragma unroll
          for (int j = 0; j < 4; ++j) w[j] = ((const GAS f32x4*)(x + (size_t)gw * DM) + lane)[64 * j]; }
      for (int m = gw; m < T; m += NGW) {
          float s = 0.f;
#pragma unroll
          for (int j = 0; j < 4; ++j) { v[j] = w[j]; s += (v[j].x * v[j].x + v[j].y * v[j].y) + (v[j].z * v[j].z + v[j].w * v[j].w); }
          if (m + NGW < T) {
#pragma unroll
              for (int j = 0; j < 4; ++j) w[j] = ((const GAS f32x4*)(x + (size_t)(m + NGW) * DM) + lane)[64 * j]; }
          const float rstd = 1.f / sqrtf(wave_sum(s) * (1.f / DM) + EPS);
          GAS unsigned long long* o8 = (GAS unsigned long long*)(U + (size_t)m * DM) + lane;
          GAS int* u8 = (GAS int*)(F.ws + WS_U8 + (size_t)m * DM) + lane;
#pragma unroll
          for (int j = 0; j < 4; ++j) { const f32x4 g = gq[j]; const float y0 = v[j].x * rstd * g.x, y1 = v[j].y * rstd * g.y, y2 = v[j].z * rstd * g.z, y3 = v[j].w * rstd * g.w;
              o8[64 * j] = (unsigned long long)pk2(y0, y1) | ((unsigned long long)pk2(y2, y3) << 32);
              int w8 = 0; w8 = __builtin_amdgcn_cvt_pk_fp8_f32(y0, y1, w8, false); w8 = __builtin_amdgcn_cvt_pk_fp8_f32(y2, y3, w8, true); u8[64 * j] = w8; } } }
}

constexpr int TAILK = 2;
constexpr int I_E13 = 16 * 16, I_E2 = 8 * 32, I_EPER = 2 * I_E13 + I_E2, NITEMS_E = NE * I_EPER;
__device__ __forceinline__ void glds16(const void* gsrc, unsigned lds_dst) { unsigned keep;
    asm volatile("s_mov_b32 %0, m0\n\ts_mov_b32 m0, %2\n\ts_nop 0\n\tglobal_load_lds_dwordx4 %1, off\n\ts_mov_b32 m0, %0" : "=&s"(keep) : "v"(gsrc), "s"(lds_dst) : "memory"); }
__device__ __forceinline__ void glds16s(const void* sbase, unsigned voff, unsigned lds_dst) { unsigned keep;
    asm volatile("s_mov_b32 %0, m0\n\ts_mov_b32 m0, %3\n\ts_nop 0\n\tglobal_load_lds_dwordx4 %1, %2\n\ts_mov_b32 m0, %0" : "=&s"(keep) : "v"(voff), "s"(sbase), "s"(lds_dst) : "memory"); }
struct ExpertItem { const float* src; int ldw; unsigned char* dst; int ldd; };
__device__ __forceinline__ ExpertItem expert_item(int it, const float* w1, const float* w3, const float* w2, unsigned char* ws) {
    ExpertItem d; const int m = it >> 14, e = (it >> 8) & 63, q = it & 255;
    if (m < 2) { const int kb = q >> 4, n0 = (q & 15) * 32;
        d.src = (m == 0 ? w1 : w3) + (size_t)e * 1024 * 512 + (size_t)(64 * kb) * 512 + n0; d.ldw = 512;
        const int drow = 256 * (n0 >> 7) + 128 * m + (n0 & 127);
        d.dst = ws + WS_W13 + ((size_t)e * 1024 + drow) * 1024 + 64 * kb; d.ldd = 1024; }
    else { const int kb = q >> 5, nb = q & 31;
        d.src = w2 + (size_t)e * 512 * 1024 + (size_t)(64 * kb) * 1024 + 32 * nb; d.ldw = 1024;
        d.dst = ws + WS_W2 + ((size_t)e * 1024 + 32 * nb) * 512 + 64 * kb; d.ldd = 512; }
    return d;
}
__device__ __forceinline__ unsigned cvtpk_(float lo, float hi) { unsigned r; asm("v_cvt_pk_bf16_f32 %0, %1, %2" : "=v"(r) : "v"(lo), "v"(hi)); return r; }
struct PrepHook {
    const float *w1, *w3, *w2; unsigned char* ws; LAS unsigned char* lds; int first, stride, s; unsigned buf;
    __device__ __forceinline__ void step(bool retired) {
        const int it = first + (s >> 2) * stride, ph = s & 3; ++s;
        if (it >= NITEMS_E) return;
        if (!retired && ph >= 2) asm volatile("s_waitcnt vmcnt(0)" ::: "memory");
        const ExpertItem d = expert_item(it, w1, w3, w2, ws); const int lane = lane_id();
        if (ph < 2) {
#pragma unroll
            for (int pp = 0; pp < 4; ++pp) { const int p = 4 * ph + pp;
                glds16s((const char*)d.src + (size_t)(32 * p) * d.ldw, (unsigned)((lane >> 3) * d.ldw * 4 + 16 * ((lane & 7) ^ p)), buf + p * 1024); asm volatile("" ::: "memory"); }
        } else {
#pragma unroll
            for (int jj = 0; jj < 2; ++jj) readback(d, 2 * (ph - 2) + jj, lane);
        }
    }
    __device__ __forceinline__ void readback(const ExpertItem& d, int j, int lane) { const int n = (lane >> 3) + 8 * j, c = lane & 7;
        const LAS float* sp = (const LAS float*)(lds + buf + (8 * c) * 128 + (((n >> 2) ^ c) << 4) + (n & 3) * 4);
        const float v[8] = {sp[0], sp[32], sp[64], sp[96], sp[128], sp[160], sp[192], sp[224]};
        typedef unsigned v2u_ __attribute__((ext_vector_type(2))); unsigned o0, o1; cvt8_fp8_x32(v, o0, o1); const v2u_ o = {o0, o1};
        asm volatile("global_store_dwordx2 %0, %1, %2" :: "v"((unsigned)((lane >> 3) * d.ldd + 8 * c)), "v"(o), "s"(d.dst + (size_t)(8 * j) * d.ldd) : "memory"); }
    __device__ __forceinline__ void whole(const ExpertItem& d, int lane) {
#pragma unroll
        for (int p = 0; p < 8; ++p) { glds16s((const char*)d.src + (size_t)(32 * p) * d.ldw, (unsigned)((lane >> 3) * d.ldw * 4 + 16 * ((lane & 7) ^ p)), buf + p * 1024); asm volatile("" ::: "memory"); }
        asm volatile("s_waitcnt vmcnt(0)" ::: "memory");
#pragma unroll
        for (int j = 0; j < 4; ++j) readback(d, j, lane);
        asm volatile("s_waitcnt lgkmcnt(0)" ::: "memory");
    }
};
struct NoHook { __device__ __forceinline__ void step(bool) {} };

__device__ __forceinline__ void unpack8(const v4u w, float (&f)[8]) { f[0] = bflo(w.x); f[1] = bfhi(w.x); f[2] = bflo(w.y); f[3] = bfhi(w.y); f[4] = bflo(w.z); f[5] = bfhi(w.z); f[6] = bflo(w.w); f[7] = bfhi(w.w); }
__device__ __forceinline__ void p2_elementwise(Frame& F, const float* conv_w) {
    const int gw = F.vcu * 8 + F.wave, NGW = F.G * 8, lane = lane_id();
    const bf16* CB = (const bf16*)(F.ws + WS_CB); const bf16* PP = (const bf16*)(F.ws + WS_CC); bf16* AC = (bf16*)(F.ws + WS_R1);
    v4u q_[6], qb_[4];
#define P2_LOAD(itn) do { const int rb_ = (itn) >> 1, c0_ = ((itn) & 1) * 512 + lane * 8, r0_ = rb_ * 4; \
        _Pragma("unroll") for (int i = 0; i < 6; ++i) { int r = r0_ - 1 + i; r = r < 0 ? 0 : (r > T - 1 ? T - 1 : r); q_[i] = *(const GAS v4u*)(PP + (size_t)r * 1024 + c0_); } \
        _Pragma("unroll") for (int i = 0; i < 4; ++i) qb_[i] = *(const GAS v4u*)(CB + (size_t)(r0_ + i) * 1024 + c0_); } while (0)
    if (gw < (T / 4) * 2) P2_LOAD(gw);
    for (int it = gw; it < (T / 4) * 2; it += NGW) {
        const int rb = it >> 1, c0 = (it & 1) * 512 + lane * 8, r0 = rb * 4, s0 = r0 & (SEQ - 1);
        v4u p_[6], cb_[4];
#pragma unroll
        for (int i = 0; i < 6; ++i) p_[i] = q_[i];
#pragma unroll
        for (int i = 0; i < 4; ++i) cb_[i] = qb_[i];
        float w0[8], w1[8], w2[8];
#pragma unroll
        for (int h = 0; h < 2; ++h) { const f32x4 a = *(const GAS f32x4*)(conv_w + c0 + 4 * h), b = *(const GAS f32x4*)(conv_w + 1024 + c0 + 4 * h), c = *(const GAS f32x4*)(conv_w + 2048 + c0 + 4 * h);
#pragma unroll
            for (int i = 0; i < 4; ++i) { w0[4 * h + i] = a[i]; w1[4 * h + i] = b[i]; w2[4 * h + i] = c[i]; } }
        if (it + NGW < (T / 4) * 2) P2_LOAD(it + NGW);
        float prev[8], cur[8], nxt[8];
        const float zf = (s0 > 0) ? 1.f : 0.f, zl = (s0 + 4 < SEQ) ? 1.f : 0.f;
        unpack8(p_[0], prev);
#pragma unroll
        for (int i = 0; i < 8; ++i) prev[i] *= zf;
        unpack8(p_[1], cur);
#pragma unroll
        for (int rr = 0; rr < 4; ++rr) {
            unpack8(p_[rr + 2], nxt);
            if (rr == 3) {
#pragma unroll
                for (int i = 0; i < 8; ++i) nxt[i] *= zl; }
            float cb8[8]; unpack8(cb_[rr], cb8); float o[8];
#pragma unroll
            for (int i = 0; i < 8; ++i) { o[i] = cb8[i] * (w0[i] * prev[i] + w1[i] * cur[i] + w2[i] * nxt[i]); prev[i] = cur[i]; cur[i] = nxt[i]; }
            v4u ov; ov.x = pk2(o[0], o[1]); ov.y = pk2(o[2], o[3]); ov.z = pk2(o[4], o[5]); ov.w = pk2(o[6], o[7]);
            *(GAS v4u*)(AC + (size_t)(r0 + rr) * 1024 + c0) = ov; }
    }
}

__device__ __forceinline__ void p6_route(Frame& F, const float* g2, int blk0, int blkstep) {
    const int lane = lane_id(), wave = F.wave, tid = wave * 64 + lane, r16 = lane & 15, q4 = lane >> 4, tt = wave & 3, kh = wave >> 2;
    constexpr int WROW = 272;
    LAS unsigned char* Wl = F.lds;
    LAS float* part = (LAS float*)(F.lds + 90112);
    LAS float* lgall = (LAS float*)(F.lds + 90112 + 21504);
    bf16* U2 = (bf16*)(F.ws + WS_R1); const bf16* Whi = (const bf16*)(F.ws + WS_WRT);
    TokRec* recs = (TokRec*)(F.ws + WS_TOK); v4u* lst = (v4u*)(F.ws + WS_LIST); unsigned* cnt = (unsigned*)(F.ctl + CW_CNT);
    LAS float* gl = (LAS float*)(F.lds + (kh ? 132096 : 87040));
    if (tid < 256) { const f32x4 gv = *(const GAS f32x4*)(g2 + tid * 4); *(LAS f32x4*)(F.lds + (tid < 128 ? 87040 + tid * 16 : 132096 + (tid - 128) * 16)) = gv; }
    LAS unsigned* lcnt = (LAS unsigned*)(F.lds + LDS_ROWTAB); LAS unsigned* lbase = lcnt + 64;
    if (tid < 64) lcnt[tid] = 0u;
    unsigned goff[10];
#pragma unroll
    for (int i = 0; i < 10; ++i) { const int q = tid + 512 * i, rowid = q >> 4, c16 = q & 15, h = rowid / 160, hl = (rowid / 80) & 1, n = rowid % 80; goff[i] = (unsigned)(hl * (NROUTE_PAD * 1024) + n * 1024 + 512 * h + 8 * c16); }
    for (int blk = blk0; blk < T / 64; blk += blkstep) {
        const int t0 = blk * 64 + tt * 16;
        const float* xr = F.out + (size_t)(t0 + r16) * DM + kh * 512 + q4 * 8;
        const LAS float* gr = gl + q4 * 8;
        unsigned char* ur = (unsigned char*)U2 + (size_t)(t0 + r16) * DM + kh * 512 + q4 * 8;
        v4u wreg[10];
#pragma unroll
        for (int i = 0; i < 10; ++i) wreg[i] = *(const GAS v4u*)(Whi + goff[i]);
        f32x4 acc[5];
#pragma unroll
        for (int nb = 0; nb < 5; ++nb) acc[nb] = (f32x4){0.f, 0.f, 0.f, 0.f};
        float ss = 0.f;
#pragma unroll 1
        for (int r = 0; r < 4; ++r) {
            f32x4 xa[4], xb[4];
#pragma unroll
            for (int s4 = 0; s4 < 4; ++s4) { xa[s4] = *(const GAS f32x4*)(xr + r * 128 + s4 * 32); xb[s4] = *(const GAS f32x4*)(xr + r * 128 + s4 * 32 + 4); }
            __syncthreads();
#pragma unroll
            for (int i = 0; i < 10; ++i) { const int q = tid + 512 * i; *(LAS v4u*)(Wl + (q >> 4) * WROW + (q & 15) * 16) = wreg[i]; }
            __syncthreads();
            if (r < 3) {
#pragma unroll
                for (int i = 0; i < 10; ++i) wreg[i] = *(const GAS v4u*)(Whi + goff[i] + (r + 1) * 128); }
#pragma unroll
            for (int s4 = 0; s4 < 4; ++s4) {
                const f32x4 ga = *(const LAS f32x4*)(gr + r * 128 + s4 * 32), gb = *(const LAS f32x4*)(gr + r * 128 + s4 * 32 + 4);
                float v[8];
#pragma unroll
                for (int i = 0; i < 4; ++i) { ss += xa[s4][i] * xa[s4][i] + xb[s4][i] * xb[s4][i]; v[i] = xa[s4][i] * ga[i]; v[4 + i] = xb[s4][i] * gb[i]; }
                v4u hv; hv.x = cvtpk_(v[0], v[1]); hv.y = cvtpk_(v[2], v[3]); hv.z = cvtpk_(v[4], v[5]); hv.w = cvtpk_(v[6], v[7]);
                v4u lv; lv.x = cvtpk_(v[0] - bflo(hv.x), v[1] - bfhi(hv.x)); lv.y = cvtpk_(v[2] - bflo(hv.y), v[3] - bfhi(hv.y));
                lv.z = cvtpk_(v[4] - bflo(hv.z), v[5] - bfhi(hv.z)); lv.w = cvtpk_(v[6] - bflo(hv.w), v[7] - bfhi(hv.w));
                { typedef unsigned v2u_ __attribute__((ext_vector_type(2))); unsigned o0, o1; cvt8_fp8(v, o0, o1); const v2u_ o8 = {o0, o1}; *(GAS v2u_*)(ur + r * 128 + s4 * 32) = o8; }
                const bf16x8 Ah = __builtin_bit_cast(bf16x8, hv), Al = __builtin_bit_cast(bf16x8, lv);
#pragma unroll
                for (int nb = 0; nb < 5; ++nb) {
                    const bf16x8 Bh = *(const LAS bf16x8*)(Wl + ((kh * 2 + 0) * NROUTE_PAD + nb * 16 + r16) * WROW + (s4 * 32 + q4 * 8) * 2);
                    const bf16x8 Bl = *(const LAS bf16x8*)(Wl + ((kh * 2 + 1) * NROUTE_PAD + nb * 16 + r16) * WROW + (s4 * 32 + q4 * 8) * 2);
                    acc[nb] = __builtin_amdgcn_mfma_f32_16x16x32_bf16(Ah, Bh, acc[nb], 0, 0, 0);
                    acc[nb] = __builtin_amdgcn_mfma_f32_16x16x32_bf16(Al, Bh, acc[nb], 0, 0, 0);
                    acc[nb] = __builtin_amdgcn_mfma_f32_16x16x32_bf16(Ah, Bl, acc[nb], 0, 0, 0); } }
        }
        if (kh == 1) {
#pragma unroll
            for (int nb = 0; nb < 5; ++nb)
#pragma unroll
                for (int rr = 0; rr < 4; ++rr) part[(tt * 21 + nb * 4 + rr) * 64 + lane] = acc[nb][rr];
            part[(tt * 21 + 20) * 64 + lane] = ss; }
        __syncthreads();
        int ea = 0, eb = 0; unsigned ra = 0u, rb = 0u; float wA = 0.f, wB = 0.f, rstd_t = 0.f;
        if (kh == 0) {
#pragma unroll
            for (int nb = 0; nb < 5; ++nb)
#pragma unroll
                for (int rr = 0; rr < 4; ++rr) acc[nb][rr] += part[(tt * 21 + nb * 4 + rr) * 64 + lane];
            ss += part[(tt * 21 + 20) * 64 + lane];
            ss += __shfl_xor(ss, 16); ss += __shfl_xor(ss, 32);
            const float rstd = 1.f / sqrtf(ss * (1.f / DM) + EPS);
            LAS float* lg = lgall + tt * 16 * NROUTE_PAD;
#pragma unroll
            for (int rr = 0; rr < 4; ++rr) { const float rs = __shfl(rstd, 4 * q4 + rr);
#pragma unroll
                for (int nb = 0; nb < 5; ++nb) lg[(4 * q4 + rr) * NROUTE_PAD + nb * 16 + r16] = acc[nb][rr] * rs; }
            LDS_WAIT(); asm volatile("" ::: "memory");
            if (lane < 16) { const LAS float* L = lg + lane * NROUTE_PAD;
                float gmax = L[0]; int g = 0;
#pragma unroll
                for (int i = 1; i < NG; ++i) { const float v = L[i]; if (v > gmax) { gmax = v; g = i; } }
                float den = 0.f;
#pragma unroll
                for (int i = 0; i < NG; ++i) den += expf(L[i] - gmax);
                const float pg = 1.f / den; const LAS float* R = L + NG + g * EPG;
                float v0 = R[0]; int i0 = 0;
#pragma unroll
                for (int i = 1; i < EPG; ++i) { const float v = R[i]; if (v > v0) { v0 = v; i0 = i; } }
                float v1 = -3.0e38f; int i1 = (i0 == 0) ? 1 : 0;
#pragma unroll
                for (int i = 0; i < EPG; ++i) { const float v = R[i]; if (i != i0 && v > v1) { v1 = v; i1 = i; } }
                const float e1 = expf(v1 - v0), w0 = 1.f / (1.f + e1), w1 = e1 / (1.f + e1);
                ea = g * EPG + i0; eb = g * EPG + i1; wA = pg * w0; wB = pg * w1; rstd_t = rstd;
                ra = __hip_atomic_fetch_add(lcnt + ea, 1u, __ATOMIC_RELAXED, __HIP_MEMORY_SCOPE_WORKGROUP); rb = __hip_atomic_fetch_add(lcnt + eb, 1u, __ATOMIC_RELAXED, __HIP_MEMORY_SCOPE_WORKGROUP); }
        }
        __syncthreads();
        if (tid < 64) { const unsigned c = lcnt[tid]; if (c) lbase[tid] = __hip_atomic_fetch_add(cnt + tid * CNT_STRIDE, c, RLX_AGENT); lcnt[tid] = 0u; }
        __syncthreads();
        if (kh == 0 && lane < 16) { const int pa = (int)(lbase[ea] + ra), pb = (int)(lbase[eb] + rb);
            v4u* rp = (v4u*)(recs + t0 + lane); rp[0] = (v4u){(unsigned)ea, (unsigned)eb, (unsigned)pa, (unsigned)pb};
            rp[1] = (v4u){__float_as_uint(wA), __float_as_uint(wB), 0u, 0u};
            const unsigned tk = (unsigned)(t0 + lane), rsb = __float_as_uint(rstd_t);
            lst[(size_t)ea * T + pa] = (v4u){tk, __float_as_uint(wA), rsb, 0u}; lst[(size_t)eb * T + pb] = (v4u){tk, __float_as_uint(wB), rsb, 0u}; }
    }
}
__device__ __forceinline__ void build_tiles(Frame& F) {
    LAS int* ps = (LAS int*)(F.lds + LDS_PSTART); LAS int* te = (LAS int*)(F.lds + LDS_TE); const int lane = lane_id();
    __syncthreads();
    if (F.wave == 0) {
        const unsigned c = __hip_atomic_load((unsigned*)(F.ctl + CW_CNT) + lane * CNT_STRIDE, RLX_AGENT); const int n = (int)((c + 255u) >> 8);
        int inc = n;
#pragma unroll
        for (int o = 1; o < 64; o <<= 1) { const int v = __shfl_up(inc, o); if (lane >= o) inc += v; }
        const int t0 = inc - n;
        ps[lane] = t0 * 256; ps[128 + lane] = n; ps[192 + lane] = (int)c; if (lane == 63) ps[64] = inc;
        for (int k = 0; k < n; ++k) te[t0 + k] = lane; }
    __syncthreads();
}
__device__ __forceinline__ void build_rowtab(Frame& F, int nunits, int i0, int reps) {
    const LAS int* ps = (const LAS int*)(F.lds + LDS_PSTART); const LAS int* te = (const LAS int*)(F.lds + LDS_TE); LAS unsigned* tab = (LAS unsigned*)(F.lds + LDS_ROWTAB);
    const unsigned* lst = (const unsigned*)(F.ws + WS_LIST); const int tid = F.wave * 64 + lane_id();
#pragma unroll
    for (int q = 0; q < ROWTAB_UNITS * 256 / 512; ++q) { const int idx = tid + 512 * q, iu = idx >> 8, r = idx & 255; int L = (i0 + iu) * F.G + F.vcu;
        unsigned off = 0u;
        if (L < nunits * reps) { L %= nunits; const int tile = L >> 2, e = te[tile], pos = tile * 256 + r - ps[e];
            if (pos < ps[192 + e]) off = lst[((size_t)e * T + pos) * 4] * (unsigned)DM; }
        tab[idx] = off; }
    __syncthreads();
}
__device__ __forceinline__ void build_rowtab_chain(Frame& F, const pg8::ChainOrder& S) {
    const LAS int* ps = (const LAS int*)(F.lds + LDS_PSTART); const LAS int* te = (const LAS int*)(F.lds + LDS_TE); LAS unsigned* tab = (LAS unsigned*)(F.lds + LDS_ROWTAB);
    const unsigned* lst = (const unsigned*)(F.ws + WS_LIST); const int tid = F.wave * 64 + lane_id();
#pragma unroll
    for (int q = 0; q < ROWTAB_UNITS * 256 / 512; ++q) { const int idx = tid + 512 * q, iu = idx >> 8, r = idx & 255; pg8::Unit u; unsigned off = 0u;
        unsigned scb = 0u;
        if (S.next(iu, u)) { const int e = te[u.pm], pos = u.pm * 256 + r - ps[e]; const bool live = pos < ps[192 + e];
            if (u.kind == 0) { if (live) { const v4u en = *(const GAS v4u*)(lst + ((size_t)e * T + pos) * 4); off = en.x * (unsigned)DM; scb = en.z; } }
            else { off = (unsigned)(u.pm * 256 + r) * (unsigned)DE; if (live) scb = lst[((size_t)e * T + pos) * 4 + 1]; } }
        tab[idx] = off; ((LAS unsigned*)(F.lds + LDS_ROWSC))[idx] = scb; }
    __syncthreads();
}
__device__ __forceinline__ void p10_combine(Frame& F, float* dst) {
    const int gw = F.vcu * 8 + F.wave, NGW = F.G * 8, lane = lane_id(); const LAS int* ps = (const LAS int*)(F.lds + LDS_PSTART);
    const unsigned char* YS = F.ws + WS_YS; const TokRec* recs = (const TokRec*)(F.ws + WS_TOK);
    for (int t0 = gw * 2; t0 < T; t0 += NGW * 2) {
        v4u r1[2]; f32x4 xv[2][4];
#pragma unroll
        for (int u = 0; u < 2; ++u) { r1[u] = *(const GAS v4u*)(recs + t0 + u); const GAS f32x4* o = (const GAS f32x4*)(F.out + (size_t)(t0 + u) * DM);
#pragma unroll
            for (int j = 0; j < 2; ++j) { xv[u][2 * j] = o[2 * (lane + 64 * j)]; xv[u][2 * j + 1] = o[2 * (lane + 64 * j) + 1]; } }
        typedef unsigned v2u_ __attribute__((ext_vector_type(2))); v2u_ ya[2][2], yb[2][2];
#pragma unroll
        for (int u = 0; u < 2; ++u) { const GAS v2u_* y0 = (const GAS v2u_*)(YS + (size_t)(ps[(int)r1[u].x] + (int)r1[u].z) * DM); const GAS v2u_* y1 = (const GAS v2u_*)(YS + (size_t)(ps[(int)r1[u].y] + (int)r1[u].w) * DM);
#pragma unroll
            for (int j = 0; j < 2; ++j) { ya[u][j] = y0[lane + 64 * j]; yb[u][j] = y1[lane + 64 * j]; } }
#pragma unroll
        for (int u = 0; u < 2; ++u) { GAS f32x4* o = (GAS f32x4*)(dst + (size_t)(t0 + u) * DM);
#pragma unroll
            for (int j = 0; j < 2; ++j) { const v2u_ a = ya[u][j], b = yb[u][j]; f32x4 p = xv[u][2 * j], q = xv[u][2 * j + 1];
                const auto a0 = __builtin_amdgcn_cvt_pk_f32_fp8((int)a.x, false), a1 = __builtin_amdgcn_cvt_pk_f32_fp8((int)a.x, true), a2 = __builtin_amdgcn_cvt_pk_f32_fp8((int)a.y, false), a3 = __builtin_amdgcn_cvt_pk_f32_fp8((int)a.y, true);
                const auto b0 = __builtin_amdgcn_cvt_pk_f32_fp8((int)b.x, false), b1 = __builtin_amdgcn_cvt_pk_f32_fp8((int)b.x, true), b2 = __builtin_amdgcn_cvt_pk_f32_fp8((int)b.y, false), b3 = __builtin_amdgcn_cvt_pk_f32_fp8((int)b.y, true);
                p.x += (a0[0] + b0[0]) * 0.0625f; p.y += (a0[1] + b0[1]) * 0.0625f; p.z += (a1[0] + b1[0]) * 0.0625f; p.w += (a1[1] + b1[1]) * 0.0625f;
                q.x += (a2[0] + b2[0]) * 0.0625f; q.y += (a2[1] + b2[1]) * 0.0625f; q.z += (a3[0] + b3[0]) * 0.0625f; q.w += (a3[1] + b3[1]) * 0.0625f;
                o[2 * (lane + 64 * j)] = p; o[2 * (lane + 64 * j) + 1] = q; } }
    }
}

constexpr int NPHASE = 11;
__device__ __forceinline__ const float* lds_arg(LAS unsigned char* lds, int k) { const volatile LAS unsigned* p = (const volatile LAS unsigned*)(lds + ARGS_OFF) + 2 * k;
    const unsigned lo = __builtin_amdgcn_readfirstlane(p[0]), hi = __builtin_amdgcn_readfirstlane(p[1]);
    return (const float*)(const __attribute__((address_space(1))) float*)(((unsigned long long)hi << 32) | lo); }
struct Args { const float* in[15]; float* out; unsigned char* ws; int ph_lo, ph_hi; int bar_region, pad; };
__global__ void __launch_bounds__(512, 2) fwd_kernel(Args args) {
    extern __shared__ __attribute__((aligned(16))) unsigned char lds[];
    Frame F;
    F.lds = (LAS unsigned char*)lds;
    F.MISC = (volatile LAS unsigned*)(F.lds + MISC_OFF);
    F.wave = __builtin_amdgcn_readfirstlane((int)threadIdx.x >> 6);
    F.G = gridDim.x; { const int bx = blockIdx.x; F.vcu = (F.G % 8 == 0) ? (bx % 8) * (F.G / 8) + bx / 8 : bx; }
    F.ws = args.ws; F.ctl = (gu32*)(args.ws + WS_CTL); F.out = args.out;
    for (int u = threadIdx.x; u < (LDS_BYTES - LDSCTL_OFF) / 4; u += 512) ((LAS unsigned*)(F.lds + LDSCTL_OFF))[u] = 0u;
    __syncthreads();
    if (threadIdx.x < 15) ((LAS unsigned long long*)(F.lds + ARGS_OFF))[threadIdx.x] = (unsigned long long)args.in[threadIdx.x];
    __syncthreads();
#define INP(k) lds_arg(F.lds, (k))
    const int lo = args.ph_lo, hi = args.ph_hi;
    const bool multi = (hi - lo) > 1;
    XcdBarrier bar; bar.wave = F.wave; bar.bar = (unsigned*)(F.ctl + CW_BAR) + args.bar_region * XCD_BAR_WORDS; bar.x = 0; bar.st = nullptr;
    if (multi) bar = xcd_barrier_post((unsigned*)(F.ctl + CW_BAR) + args.bar_region * XCD_BAR_WORDS, F.MISC + 8, F.wave);
#define IN(k) (lo <= (k) && (k) < hi)
#define SEAM(k) do { if (IN(k) && IN((k) + 1)) xcd_barrier(bar); } while (0)
#ifndef MK_REP_MASK
#define MK_REP_MASK 0
#endif
#define REPS(k) for (int rep_ = 0; rep_ < (((MK_REP_MASK >> (k)) & 1) ? 2 : 1); ++rep_)
#define REPBAR() do { if (rep_) xcd_barrier(bar); } while (0)
#define REPK(k) (((MK_REP_MASK >> (k)) & 1) ? 2 : 1)
    unsigned char* ws = args.ws;

    const bool p01 = (F.G == 256) && IN(0) && IN(1) && IN(2) && (MK_REP_MASK & 0x3) == 0;
    if (IN(0)) REPS(0) { REPBAR(); p0_prologue(F, INP(0), INP(1), INP(2), INP(6), INP(7), INP(8), INP(10), INP(11), p01 ? 1 : 0, 0, 0); } SEAM(0);
    if (IN(1)) {
        { pg8::GateOrder S8{F.G, (int)blockIdx.x};
          LAS unsigned* tab = (LAS unsigned*)(F.lds + LDS_ROWTAB); const int tid_ = F.wave * 64 + lane_id();
#pragma unroll
          for (int q = 0; q < ROWTAB_UNITS * 256 / 512; ++q) { const int idx = tid_ + 512 * q; pg8::Unit u; tab[idx] = S8.next(idx >> 8, u) ? (unsigned)(u.pm * 256 + (idx & 255)) * (unsigned)DM : 0u; }
          __syncthreads();
        }
        { pg8::Gemm g{(const pg8::bf16_t*)(ws + WS_R1), (const pg8::bf16_t*)(ws + WS_WIN), T, N8_0, DM}; pg8::StaticOrder S; S.init(T, N8_0, F.G, (int)blockIdx.x, REPK(1));
          pg8::EpiProj E{ws, INP(4), INP(5), (LAS float*)(F.lds + LDS_ROWTAB)};
          pg8::gemm_phase<pg8::EpiProj, pg8::StaticOrder, true, true>(F.lds, g, S, E, F.wave); }
        __syncthreads();
        { pg8::GateOrder S8{F.G, (int)blockIdx.x};
          pg8::Gemm g8{(const pg8::bf16_t*)(ws + WS_U8), (const pg8::bf16_t*)(ws + WS_W8), 0, 0, DM / 2, (const pg8::bf16_t*)(ws + WS_U8), (const pg8::bf16_t*)(ws + WS_W8), DM / 2};
          pg8::EpiGate E8{pg8::EpiProj{ws, INP(4), INP(5), (LAS float*)(F.lds + LDS_ROWSC), 0.03125f}};
          pg8::gemm_phase<pg8::EpiGate, pg8::GateOrder, true, true, true, true, true>(F.lds, g8, S8, E8, F.wave, (const LAS unsigned*)(F.lds + LDS_ROWTAB));
          __syncthreads(); }
        if (p01 && (int)blockIdx.x >= 128) p0_prologue(F, INP(0), INP(1), INP(2), INP(6), INP(7), INP(8), INP(10), INP(11), 2, ((int)blockIdx.x - 128) * 8 + F.wave, 1024);
        if (p01 && (int)blockIdx.x >= 128) {
            __syncthreads();
            PrepHook tk{INP(12), INP(13), INP(14), ws, F.lds, 0, 0, 0, (unsigned)(PREP_OFF + F.wave * PREP_BYTES)};
            for (int it = ((int)blockIdx.x - 128) * 8 + F.wave; it < TAILK * 2048; it += 1024) { const ExpertItem d = expert_item(it, INP(12), INP(13), INP(14), ws); tk.whole(d, lane_id()); }
            __syncthreads(); }
    } SEAM(1);
    if (IN(2)) REPS(2) { REPBAR(); p2_elementwise(F, INP(3)); }
    do { if (IN(2) && !IN(3) && IN(4)) xcd_barrier(bar); } while (0);
    if (IN(3)) {
        PrepHook hk{INP(12), INP(13), INP(14), ws, F.lds, F.vcu * 8 + F.wave, F.G * 8, p01 ? 4 * TAILK : 0, (unsigned)(PREP_OFF + F.wave * PREP_BYTES)};
        NoHook nohk; bool fast_sm;
        { const int l_ = lane_id(); float gq = fmaxf(fabsf(INP(4)[l_]), fabsf(INP(4)[l_ + 64])), gk = fmaxf(fabsf(INP(5)[l_]), fabsf(INP(5)[l_ + 64]));
#pragma unroll
          for (int o_ = 1; o_ < 64; o_ <<= 1) { gq = fmaxf(gq, __shfl_xor(gq, o_)); gk = fmaxf(gk, __shfl_xor(gk, o_)); }
          const float bound_log2 = attn::SCALE * 128.f * gq * gk * 1.02f * 1.4426950408889634f;
          fast_sm = __builtin_amdgcn_readfirstlane(!(bound_log2 < 64.f) ? 0 : 1) != 0; }
        for (int un_ = F.vcu; un_ < BATCH * NH * (SEQ / 256) * REPK(3); un_ += F.G) { const int un = un_ & 511;
            const int pair = un >> 6, idx = un & 63, b = pair >> 1, kvh = pair & 1, h = kvh * 4 + (idx >> 4), qb = idx & 15;
            const size_t row0 = (size_t)b * SEQ;
            if (fast_sm) attn::attn_dense_body<true>((const attn::bf16*)(ws + WS_Q + ((row0 + (size_t)qb * 256) * 1024 + h * 128))  , (const attn::bf16*)(ws + WS_K + (row0 * 256 + kvh * 128))  ,
                                  (const attn::bf16*)(ws + WS_V + (size_t)((b * 2 + kvh) * 128) * SEQ)  , (attn::bf16*)(ws + WS_ATTO + ((row0 + (size_t)qb * 256) * 1024 + h * 128))  , SEQ, (char*)lds, hk, F.wave);
            else attn::attn_dense_body<false>((const attn::bf16*)(ws + WS_Q + ((row0 + (size_t)qb * 256) * 1024 + h * 128))  , (const attn::bf16*)(ws + WS_K + (row0 * 256 + kvh * 128))  ,
                                  (const attn::bf16*)(ws + WS_V + (size_t)((b * 2 + kvh) * 128) * SEQ)  , (attn::bf16*)(ws + WS_ATTO + ((row0 + (size_t)qb * 256) * 1024 + h * 128))  , SEQ, (char*)lds, nohk, F.wave);
            __syncthreads();
        }
        VM_WAIT(); __syncthreads();
        for (int it = hk.first + (hk.s >> 2) * hk.stride; it < NITEMS_E; it += hk.stride) { const ExpertItem d = expert_item(it, INP(12), INP(13), INP(14), ws); hk.whole(d, lane_id()); }
        __syncthreads();
    } SEAM(3);
    if (IN(4)) {
        { pg8::Gemm g{(const pg8::bf16_t*)(ws + WS_R1), (const pg8::bf16_t*)(ws + WS_WC), T, DM, DM}; pg8::StaticOrder S; S.init(T, DM, F.G, (int)blockIdx.x, REPK(4));
          pg8::EpiPlain E{(pg8::bf16_t*)(ws + WS_YCONV), DM};
          pg8::gemm_phase<pg8::EpiPlain, pg8::StaticOrder, true, true>(F.lds, g, S, E, F.wave); }
        __syncthreads();
        { pg8::TileOrder S8; S8.so.init(T, DM, F.G, (int)blockIdx.x, REPK(4));
          LAS unsigned* tab = (LAS unsigned*)(F.lds + LDS_ROWTAB); const int tid_ = F.wave * 64 + lane_id();
#pragma unroll
          for (int q = 0; q < ROWTAB_UNITS * 256 / 512; ++q) { const int idx = tid_ + 512 * q; pg8::Unit u; tab[idx] = S8.next(idx >> 8, u) ? (unsigned)(u.pm * 256 + (idx & 255)) * (unsigned)DM : 0u; }
          __syncthreads();
          pg8::Gemm g8{(const pg8::bf16_t*)(ws + WS_ATTO), (const pg8::bf16_t*)(ws + WS_WA), 0, 0, DM / 2, (const pg8::bf16_t*)(ws + WS_ATTO), (const pg8::bf16_t*)(ws + WS_WA), DM / 2};
          pg8::EpiMerge E8{(const pg8::bf16_t*)(ws + WS_GC), (const pg8::bf16_t*)(ws + WS_GA), (const pg8::bf16_t*)(ws + WS_YCONV), (pg8::bf16_t*)(ws + WS_MERGED), 1.f / 2048.f};
          pg8::gemm_phase<pg8::EpiMerge, pg8::TileOrder, true, true, true, true, true>(F.lds, g8, S8, E8, F.wave, (const LAS unsigned*)(F.lds + LDS_ROWTAB));
          __syncthreads(); }
    } SEAM(4);
    const bool p56 = (F.G == 256) && IN(5) && IN(6) && (MK_REP_MASK & 0x60) == 0;
    if (IN(5)) {
        pg8::Gemm g{(const pg8::bf16_t*)(ws + WS_MERGED), (const pg8::bf16_t*)(ws + WS_WO), T, DM, DM}; pg8::StaticOrder S; S.init(T, DM, F.G, (int)blockIdx.x, REPK(5));
        pg8::EpiResid E{INP(0), F.out, p56};
        pg8::gemm_phase<pg8::EpiResid, pg8::StaticOrder, true, true>(F.lds, g, S, E, F.wave);
        if (p56) { pg8::Unit u5; if (S.next(0, u5)) {
            gu32* pc = F.ctl + CW_PANEL + 64 * u5.pm;
            asm volatile("s_waitcnt vmcnt(0)" ::: "memory"); __syncthreads();
            if (F.wave == 0 && lane_id() == 0) { (void)__hip_atomic_fetch_add((unsigned*)pc, 1u, RLX_AGENT);
                unsigned sp = 0; while (__hip_atomic_load((unsigned*)pc, RLX_AGENT) < 4u) { __builtin_amdgcn_s_sleep(2); if (++sp > (1u << 22)) break; }
                __builtin_amdgcn_fence(__ATOMIC_ACQUIRE, "agent"); asm volatile("s_waitcnt vmcnt(0)" ::: "memory"); }
            __syncthreads();
            p6_route(F, INP(9), u5.pm * 4 + u5.pn, T / 64); } }
    } do { if (IN(5) && IN(6) && !p56) xcd_barrier(bar); } while (0);
    if (IN(6) && !p56) REPS(6) { if (rep_) { xcd_barrier(bar); if (blockIdx.x == 0 && F.wave == 0) __hip_atomic_store((unsigned*)(F.ctl + CW_CNT) + lane_id() * CNT_STRIDE, 0u, RLX_AGENT); xcd_barrier(bar); }
        p6_route(F, INP(9), F.vcu, F.G); } do { if (IN(6) && IN(8)) xcd_barrier(bar); } while (0);
    const bool moe_chain = (F.G == 256) && IN(8) && IN(9) && (MK_REP_MASK & 0x300) == 0;
    if (moe_chain) {
        build_tiles(F);
        const int nt = ((const LAS int*)(F.lds + LDS_PSTART))[64];
        pg8::ChainOrder S{nt, F.G, F.vcu, (const LAS int*)(F.lds + LDS_TE), (unsigned*)(F.ctl + CW_TILERDY), (unsigned*)(F.ctl + CW_BAR) + XB_TMO, F.wave == 0};
        build_rowtab_chain(F, S);
        pg8::Gemm g{(const pg8::bf16_t*)(ws + WS_R1), (const pg8::bf16_t*)(ws + WS_W13), 0, 0, DM / 2, (const pg8::bf16_t*)(ws + WS_H), (const pg8::bf16_t*)(ws + WS_W2), DE / 2};
        pg8::EpiChain E{pg8::EpiSwiGLU{(pg8::bf16_t*)(ws + WS_H), (const unsigned*)(ws + WS_LIST), (const LAS int*)(F.lds + LDS_PSTART), true, (const LAS float*)(F.lds + LDS_ROWSC)},
                        pg8::EpiMoeOut{(const unsigned*)(ws + WS_LIST), (const LAS int*)(F.lds + LDS_PSTART), (pg8::bf16_t*)(ws + WS_YS), (const LAS float*)(F.lds + LDS_ROWSC)}};
        pg8::gemm_phase<pg8::EpiChain, pg8::ChainOrder, true, true, true, true, true>(F.lds, g, S, E, F.wave, (const LAS unsigned*)(F.lds + LDS_ROWTAB));
        xcd_barrier(bar);
    }
    if ((IN(8) || IN(9)) && !moe_chain) {
        build_tiles(F);
        const int nt = ((const LAS int*)(F.lds + LDS_PSTART))[64];
        pg8::Gemm g{(const pg8::bf16_t*)(ws + WS_R1), (const pg8::bf16_t*)(ws + WS_W13), 0, 0, DM / 2, (const pg8::bf16_t*)(ws + WS_H), (const pg8::bf16_t*)(ws + WS_W2), DE / 2};
        pg8::EpiChain E{pg8::EpiSwiGLU{(pg8::bf16_t*)(ws + WS_H), (const unsigned*)(ws + WS_LIST), (const LAS int*)(F.lds + LDS_PSTART), true, (const LAS float*)(F.lds + LDS_ROWSC)},
                        pg8::EpiMoeOut{(const unsigned*)(ws + WS_LIST), (const LAS int*)(F.lds + LDS_PSTART), (pg8::bf16_t*)(ws + WS_YS), (const LAS float*)(F.lds + LDS_ROWSC)}};
        for (int pass = 1; pass <= 2; ++pass) {
            if (pass == 2 && IN(8) && IN(9)) xcd_barrier(bar);
            if (!IN(7 + pass)) continue;
            for (int i0 = 0; i0 * F.G + F.vcu < nt * 4; i0 += ROWTAB_UNITS) {
                pg8::ChainOrder S{nt, F.G, F.vcu, (const LAS int*)(F.lds + LDS_TE), (unsigned*)(F.ctl + CW_TILERDY), (unsigned*)(F.ctl + CW_BAR) + XB_TMO, F.wave == 0, pass, i0, ROWTAB_UNITS};
                build_rowtab_chain(F, S);
                pg8::gemm_phase<pg8::EpiChain, pg8::ChainOrder, true, true, true, true, true>(F.lds, g, S, E, F.wave, (const LAS unsigned*)(F.lds + LDS_ROWTAB));
                __syncthreads();
            }
        }
    } do { if (IN(9) && IN(10) && !moe_chain) xcd_barrier(bar); } while (0);
    if (IN(10)) REPS(10) { REPBAR(); if (!IN(8)) build_tiles(F); p10_combine(F, (((MK_REP_MASK >> 10) & 1) && rep_ == 0) ? (float*)(ws + WS_GC) : F.out); }
#undef IN
#undef SEAM
}

#ifndef MK_ONE_LAUNCH
#define MK_ONE_LAUNCH 1
#endif
extern "C" void kernel_launch(void* const* d_in, const int* in_sizes, int n_in, void* d_out, int out_size, void* d_ws, size_t ws_size, hipStream_t stream) {
    static int grid = 0;
    if (grid == 0) {
        if (n_in != 15 || in_sizes[0] != T * DM || out_size != T * DM || ws_size < WS_END) { fprintf(stderr, "kernel_launch: shape/workspace mismatch (n_in %d, in0 %d, out %d, ws %zu, need %zu)\n", n_in, n_in > 0 ? in_sizes[0] : -1, out_size, ws_size, (size_t)WS_END); grid = -1; return; }
        int dev = 0, cus = 0, per_cu = 0;
        if (hipGetDevice(&dev) != hipSuccess || hipDeviceGetAttribute(&cus, hipDeviceAttributeMultiprocessorCount, dev) != hipSuccess) { grid = -1; return; }
        if (hipFuncSetAttribute((const void*)fwd_kernel, hipFuncAttributeMaxDynamicSharedMemorySize, LDS_BYTES) != hipSuccess) { fprintf(stderr, "kernel_launch: hipFuncSetAttribute failed\n"); grid = -1; return; }
        if (hipOccupancyMaxActiveBlocksPerMultiprocessor(&per_cu, (const void*)fwd_kernel, 512, LDS_BYTES) != hipSuccess || per_cu < 1) { fprintf(stderr, "kernel_launch: occupancy query says %d blocks per CU\n", per_cu); (void)hipGetLastError(); grid = -1; return; }
        grid = cus;
    }
    if (grid < 0) return;
    (void)hipMemsetAsync((char*)d_ws + WS_CTL, 0, CTL_ZERO_BYTES, stream);
    Args a{};
    for (int i = 0; i < 15; ++i) a.in[i] = (const float*)d_in[i];
    a.out = (float*)d_out; a.ws = (unsigned char*)d_ws;
#if MK_ONE_LAUNCH
    a.ph_lo = 0; a.ph_hi = NPHASE;
    hipLaunchKernelGGL(fwd_kernel, dim3(grid), dim3(512), LDS_BYTES, stream, a);
#ifdef MK_RERUN_HI
    a.ph_lo = MK_RERUN_LO; a.ph_hi = MK_RERUN_HI; a.bar_region = 1;
    hipLaunchKernelGGL(fwd_kernel, dim3(grid), dim3(512), LDS_BYTES, stream, a);
#endif
#else
    for (int p = 0; p < NPHASE; ++p) { a.ph_lo = p; a.ph_hi = p + 1; hipLaunchKernelGGL(fwd_kernel, dim3(grid), dim3(512), LDS_BYTES, stream, a); }
#endif
    const hipError_t le = hipPeekAtLastError();
    if (le != hipSuccess) fprintf(stderr, "kernel_launch: launch failed: %s\n", hipGetErrorName(le));
}
```
